# Optimizing an MI355X kernel written in HIP

```python
import jax, jax.numpy as jnp
from jax import lax
import numpy as np

D_MODEL = 2048
BATCH = 8
SEQ = 2048
DEPTH = 1

HEAD_DIM = 64
N_Q_HEADS = 32
N_KV_HEADS = 4
GROUP = N_Q_HEADS // N_KV_HEADS
WINDOW = 128
ATT_BLOCK = 128
ATT_Q_W = N_Q_HEADS * HEAD_DIM
ATT_KV_W = N_KV_HEADS * HEAD_DIM
ATT_W = ATT_Q_W

DN_K_HEADS = 16
DN_V_HEADS = 32
DN_K_DIM = 128
DN_V_DIM = 128
V_PER_K = DN_V_HEADS // DN_K_HEADS
DN_QK_W = DN_K_HEADS * DN_K_DIM
DN_V_W = DN_V_HEADS * DN_V_DIM
DN_CONV_CH = 2 * DN_QK_W + DN_V_W
CONV_WIDTH = 4
CHUNK = 64

N_BRANCH = 2
EPS = 1e-6

OFF_AQ = 0
OFF_AK = OFF_AQ + ATT_Q_W
OFF_AV = OFF_AK + ATT_KV_W
OFF_AZ = OFF_AV + ATT_KV_W
OFF_DQKV = OFF_AZ + ATT_W
OFF_DZ = OFF_DQKV + DN_CONV_CH
OFF_DB = OFF_DZ + DN_V_W
OFF_DA = OFF_DB + DN_V_HEADS
OFF_G = OFF_DA + DN_V_HEADS
IN_W = OFF_G + N_BRANCH * D_MODEL
ATT_QKV_W = ATT_Q_W + 2 * ATT_KV_W

kernel_name = "hybrid_swa_sink_gated_deltanet_parallel"


def rms_norm(x, w):
    xf = x.astype(jnp.float32)
    y = xf * lax.rsqrt(jnp.mean(xf * xf, axis=-1, keepdims=True) + EPS)
    return (y * w.astype(jnp.float32)).astype(x.dtype)


def l2_norm(x):
    xf = x.astype(jnp.float32)
    return xf * lax.rsqrt(jnp.sum(xf * xf, axis=-1, keepdims=True) + EPS)


def sliding_window_attention(q, k, v, sinks):
    B, S = q.shape[0], q.shape[1]
    L = ATT_BLOCK
    nb = S // L
    scale = HEAD_DIM ** -0.5
    qb = q.reshape(B, nb, L, N_KV_HEADS, GROUP, HEAD_DIM).transpose(1, 0, 2, 3, 4, 5)
    pad = jnp.zeros((B, L, N_KV_HEADS, HEAD_DIM), k.dtype)
    kp = jnp.concatenate([pad, k], axis=1).reshape(B, nb + 1, L, N_KV_HEADS, HEAD_DIM)
    vp = jnp.concatenate([pad, v], axis=1).reshape(B, nb + 1, L, N_KV_HEADS, HEAD_DIM)
    kw = jnp.concatenate([kp[:, :-1], kp[:, 1:]], axis=2).transpose(1, 0, 2, 3, 4)
    vw = jnp.concatenate([vp[:, :-1], vp[:, 1:]], axis=2).transpose(1, 0, 2, 3, 4)
    qi = jnp.arange(L)[:, None]
    ki = jnp.arange(2 * L)[None, :]
    rel = qi + L - ki
    band = (rel >= 0) & (rel < WINDOW)
    key_valid = (jnp.arange(nb)[:, None] * L - L + jnp.arange(2 * L)[None, :]) >= 0
    sink = sinks.astype(jnp.float32).reshape(N_KV_HEADS, GROUP)[None, :, :, None, None]

    def one_block(args):
        q_blk, k_blk, v_blk, kv_ok = args
        s = jnp.einsum('bqhgd,bkhd->bhgqk', q_blk, k_blk).astype(jnp.float32) * scale
        s = jnp.where((band & kv_ok[None, :])[None, None, None], s, -jnp.inf)
        m = jnp.maximum(jnp.max(s, axis=-1, keepdims=True), sink)
        p = jnp.exp(s - m)
        p = p / (jnp.sum(p, axis=-1, keepdims=True) + jnp.exp(sink - m))
        return jnp.einsum('bhgqk,bkhd->bqhgd', p.astype(v_blk.dtype), v_blk)

    o = lax.map(one_block, (qb, kw, vw, key_valid))
    return o.transpose(1, 0, 2, 3, 4, 5).reshape(B, S, N_Q_HEADS * HEAD_DIM)


def causal_depthwise_conv(u, w):
    S = u.shape[1]
    up = jnp.pad(u, ((0, 0), (CONV_WIDTH - 1, 0), (0, 0)))
    y = up[:, 0:S] * w[0]
    for i in range(1, CONV_WIDTH):
        y = y + up[:, i:i + S] * w[i]
    return y


def gated_delta_rule(q, k, v, g, beta):
    B, S, H, DK = q.shape
    DV = v.shape[-1]
    N = S // CHUNK
    f32 = jnp.float32

    def chunks(t):
        return t.astype(f32).reshape(B, N, CHUNK, H, -1).transpose(0, 3, 1, 2, 4)

    q = chunks(q) * (DK ** -0.5)
    k = chunks(k)
    v = chunks(v)
    beta = beta.astype(f32).reshape(B, N, CHUNK, H).transpose(0, 3, 1, 2)
    g = jnp.cumsum(g.astype(f32).reshape(B, N, CHUNK, H).transpose(0, 3, 1, 2), axis=-1)
    k_beta = k * beta[..., None]
    v_beta = v * beta[..., None]
    tril = jnp.tril(jnp.ones((CHUNK, CHUNK), bool))
    strict = jnp.tril(jnp.ones((CHUNK, CHUNK), bool), -1)
    decay = jnp.exp(jnp.where(tril, g[..., :, None] - g[..., None, :], -jnp.inf))
    a_low = jnp.where(strict, jnp.einsum('bhncd,bhnkd->bhnck', k_beta, k) * decay, 0.0)
    lhs = a_low + jnp.eye(CHUNK, dtype=f32)
    rhs = jnp.concatenate([v_beta, k_beta * jnp.exp(g)[..., None]], axis=-1)
    sol = lax.linalg.triangular_solve(lhs, rhs, left_side=True, lower=True, unit_diagonal=True)
    u = sol[..., :DV]
    w = sol[..., DV:]
    qk = jnp.einsum('bhncd,bhnkd->bhnck', q, k) * decay

    def to_scan(t):
        return jnp.moveaxis(t, 2, 0)

    def step(state, inp):
        q_i, k_i, u_i, w_i, g_i, qk_i = inp
        v_new = u_i - jnp.einsum('bhcd,bhde->bhce', w_i, state)
        o = (jnp.einsum('bhcd,bhde->bhce', q_i * jnp.exp(g_i)[..., None], state)
             + jnp.einsum('bhck,bhke->bhce', qk_i, v_new))
        g_last = g_i[..., -1]
        k_dec = k_i * jnp.exp(g_last[..., None] - g_i)[..., None]
        state = state * jnp.exp(g_last)[..., None, None] + jnp.einsum('bhcd,bhce->bhde', k_dec, v_new)
        return state, o

    state0 = jnp.zeros((B, H, DK, DV), f32)
    _, o = lax.scan(step, state0, (to_scan(q), to_scan(k), to_scan(u), to_scan(w), to_scan(g), to_scan(qk)))
    return o.transpose(1, 0, 3, 2, 4).reshape(B, S, H, DV)


def setup_inputs(seed: int = 0) -> dict:
    key = jax.random.key(seed)
    ks = jax.random.split(key, 16)
    f32 = jnp.float32
    nrm = lambda k, shape, s: jax.random.normal(k, shape, f32) * s
    return {
        "x": jax.random.normal(ks[0], (BATCH, SEQ, D_MODEL), f32),
        "norm_w": 1.0 + nrm(ks[1], (DEPTH, D_MODEL), 0.02),
        "w_in": nrm(ks[2], (DEPTH, D_MODEL, IN_W), D_MODEL ** -0.5),
        "b_qkv": nrm(ks[3], (DEPTH, ATT_QKV_W), 0.02),
        "sinks": nrm(ks[4], (DEPTH, N_Q_HEADS), 0.5),
        "conv_w": nrm(ks[5], (DEPTH, CONV_WIDTH, DN_CONV_CH), CONV_WIDTH ** -0.5),
        "a_log": jnp.log(jax.random.uniform(ks[6], (DEPTH, DN_V_HEADS), f32, 1.0, 16.0)),
        "dt_bias": 1.0 + nrm(ks[7], (DEPTH, DN_V_HEADS), 0.1),
        "dn_norm_w": 1.0 + nrm(ks[8], (DEPTH, DN_V_DIM), 0.02),
        "w_att_branch": nrm(ks[9], (DEPTH, ATT_W, D_MODEL), ATT_W ** -0.5),
        "w_dn_branch": nrm(ks[10], (DEPTH, DN_V_W, D_MODEL), DN_V_W ** -0.5),
        "w_out": nrm(ks[11], (DEPTH, D_MODEL, D_MODEL), D_MODEL ** -0.5),
        "final_norm_w": 1.0 + nrm(ks[12], (D_MODEL,), 0.02),
    }


def reference(x, norm_w, w_in, b_qkv, sinks, conv_w, a_log, dt_bias, dn_norm_w,
              w_att_branch, w_dn_branch, w_out, final_norm_w):
    B, S, _ = x.shape
    for l in range(DEPTH):
        h = rms_norm(x, norm_w[l])
        proj = jnp.einsum('bsd,de->bse', h, w_in[l])

        qkv = proj[..., OFF_AQ:OFF_AZ] + b_qkv[l]
        q_a = qkv[..., :ATT_Q_W].reshape(B, S, N_Q_HEADS, HEAD_DIM)
        k_a = qkv[..., ATT_Q_W:ATT_Q_W + ATT_KV_W].reshape(B, S, N_KV_HEADS, HEAD_DIM)
        v_a = qkv[..., ATT_Q_W + ATT_KV_W:].reshape(B, S, N_KV_HEADS, HEAD_DIM)
        o_a = sliding_window_attention(q_a, k_a, v_a, sinks[l])
        o_a = o_a * jax.nn.silu(proj[..., OFF_AZ:OFF_DQKV])
        y_a = jnp.einsum('bse,ed->bsd', o_a, w_att_branch[l])

        mixed = jax.nn.silu(causal_depthwise_conv(proj[..., OFF_DQKV:OFF_DZ], conv_w[l]))
        q_d = l2_norm(mixed[..., :DN_QK_W].reshape(B, S, DN_K_HEADS, DN_K_DIM))
        k_d = l2_norm(mixed[..., DN_QK_W:2 * DN_QK_W].reshape(B, S, DN_K_HEADS, DN_K_DIM))
        v_d = mixed[..., 2 * DN_QK_W:].reshape(B, S, DN_V_HEADS, DN_V_DIM)
        q_d = jnp.repeat(q_d, V_PER_K, axis=2)
        k_d = jnp.repeat(k_d, V_PER_K, axis=2)
        beta = jax.nn.sigmoid(proj[..., OFF_DB:OFF_DA].astype(jnp.float32))
        g = -jnp.exp(a_log[l].astype(jnp.float32)) * jax.nn.softplus(
            proj[..., OFF_DA:OFF_G].astype(jnp.float32) + dt_bias[l].astype(jnp.float32))
        o_d = gated_delta_rule(q_d, k_d, v_d, g, beta).astype(x.dtype)
        z_d = proj[..., OFF_DZ:OFF_DB].reshape(B, S, DN_V_HEADS, DN_V_DIM)
        o_d = rms_norm(o_d, dn_norm_w[l]) * jax.nn.silu(z_d)
        y_d = jnp.einsum('bse,ed->bsd', o_d.reshape(B, S, DN_V_W), w_dn_branch[l])

        gates = jax.nn.sigmoid(proj[..., OFF_G:].astype(jnp.float32)).astype(x.dtype)
        merged = gates[..., :D_MODEL] * y_a + gates[..., D_MODEL:] * y_d
        x = x + jnp.einsum('bsd,de->bse', merged, w_out[l])
    return rms_norm(x, final_norm_w)
```

```cpp
#include <hip/hip_runtime.h>
#include <hip/hip_cooperative_groups.h>
#include <cstdio>
namespace cg = cooperative_groups;

#define LAS __attribute__((address_space(3)))
#define DI __device__ __forceinline__
typedef unsigned short bf16_t;
typedef short bf16x8 __attribute__((ext_vector_type(8)));
typedef short bf16x4 __attribute__((ext_vector_type(4)));
typedef float f32x4 __attribute__((ext_vector_type(4)));
typedef unsigned u32x4 __attribute__((ext_vector_type(4)));
typedef unsigned u32x2 __attribute__((ext_vector_type(2)));

constexpr int MTOK = 16384, DM = 2048, SEQ = 2048;
constexpr int N1 = 17152;
constexpr size_t MB = 1u << 20;
constexpr size_t WS_WIN_T = 0;
constexpr size_t WS_W2A_T = WS_WIN_T + (size_t)N1 * 2048 * 2;
constexpr size_t WS_W2B_T = WS_W2A_T + (size_t)2048 * 4096 * 2;
constexpr size_t WS_WDN_T = WS_W2B_T + (size_t)2048 * 4096 * 2;
constexpr size_t WS_WOUT_T = WS_WDN_T + (size_t)2048 * 4096 * 2;
constexpr size_t WS_QKVA = WS_WOUT_T + (size_t)2048 * 2048 * 2;
constexpr size_t WS_DQKV = WS_QKVA + (size_t)MTOK * 2560 * 2;
constexpr size_t WS_DZ = WS_DQKV + (size_t)MTOK * 8192 * 2;
constexpr size_t WS_BETA = WS_DZ + (size_t)MTOK * 4096 * 2;
constexpr size_t WS_G = WS_BETA + (size_t)MTOK * 32 * 4;
constexpr size_t WS_BAR = WS_G + (size_t)MTOK * 32 * 4;
constexpr size_t WS_BAR_BYTES = 16384;
constexpr size_t WS_END = WS_BAR + WS_BAR_BYTES;
constexpr size_t WS_GSCR = WS_DQKV;
constexpr size_t WS_PART = WS_DQKV + 64 * MB;

constexpr int LDS_BYTES = 153600;

struct Params {
    const float* x; const float* norm_w; const float* w_in; const float* b_qkv; const float* sinks; const float* conv_w;
    const float* a_log; const float* dt_bias; const float* dn_norm_w; const float* w_att; const float* w_dn; const float* w_out;
    const float* final_w; float* out; unsigned char* ws;
};

typedef __bf16 bf2_t __attribute__((ext_vector_type(2)));
typedef float f32x2 __attribute__((ext_vector_type(2)));
DI unsigned pk_bf16(float lo, float hi) { f32x2 v = {lo, hi}; bf2_t b = __builtin_convertvector(v, bf2_t); return __builtin_bit_cast(unsigned, b); }
DI int fresh_tid() { int t = threadIdx.x; asm volatile("" : "+v"(t)); return t; }
DI float bf2f(unsigned short b) { return __uint_as_float(((unsigned)b) << 16); }
DI float bflo(unsigned u) { return __uint_as_float(u << 16); }
DI float bfhi(unsigned u) { return __uint_as_float(u & 0xffff0000u); }
DI float sigmoidf_(float x) { return __builtin_amdgcn_rcpf(1.f + __expf(-x)); }
DI float siluf_(float x) { return x * sigmoidf_(x); }
DI f32x4 mfma32(bf16x8 a, bf16x8 b, f32x4 c) { return __builtin_amdgcn_mfma_f32_16x16x32_bf16(a, b, c, 0, 0, 0); }
DI f32x4 mfma16(bf16x4 a, bf16x4 b, f32x4 c) { return __builtin_amdgcn_mfma_f32_16x16x16bf16_1k(a, b, c, 0, 0, 0); }
DI bf16x4 pack4(float a, float b, float c, float d) { u32x2 w; w.x = pk_bf16(a, b); w.y = pk_bf16(c, d); return __builtin_bit_cast(bf16x4, w); }
DI bf16x8 pack8(f32x4 a, f32x4 b) { u32x4 w; w.x = pk_bf16(a[0], a[1]); w.y = pk_bf16(a[2], a[3]); w.z = pk_bf16(b[0], b[1]); w.w = pk_bf16(b[2], b[3]); return __builtin_bit_cast(bf16x8, w); }
DI bf16x8 lds16(LAS unsigned char* L, int off) { return *(const LAS bf16x8*)(L + off); }
DI bf16x4 lds8(LAS unsigned char* L, int off) { return *(const LAS bf16x4*)(L + off); }
DI bf16x8 lds_perm(LAS unsigned char* L, int off) {
    bf16x4 lo = *(const LAS bf16x4*)(L + off), hi = *(const LAS bf16x4*)(L + off + 32);
    return __builtin_shufflevector(lo, hi, 0, 1, 2, 3, 4, 5, 6, 7);
}
DI bf16x4 lds_tr(LAS unsigned char* L, int off) { return __builtin_amdgcn_ds_read_tr16_b64_v4i16((LAS bf16x4*)(L + off)); }
DI bf16x8 cat8(bf16x4 lo, bf16x4 hi) { return __builtin_shufflevector(lo, hi, 0, 1, 2, 3, 4, 5, 6, 7); }
DI float sum16(float v) {
    v += __builtin_bit_cast(float, __builtin_amdgcn_mov_dpp(__builtin_bit_cast(int, v), 0xB1, 0xf, 0xf, true));
    v += __builtin_bit_cast(float, __builtin_amdgcn_mov_dpp(__builtin_bit_cast(int, v), 0x4E, 0xf, 0xf, true));
    v += __builtin_bit_cast(float, __builtin_amdgcn_mov_dpp(__builtin_bit_cast(int, v), 0x141, 0xf, 0xf, true));
    v += __builtin_bit_cast(float, __builtin_amdgcn_mov_dpp(__builtin_bit_cast(int, v), 0x140, 0xf, 0xf, true));
    return v;
}
DI void lds_barrier() { asm volatile("s_waitcnt lgkmcnt(0)\n\ts_barrier" ::: "memory"); }
DI void st8(LAS unsigned char* L, int off, bf16x4 v) { *(LAS bf16x4*)(L + off) = v; }

namespace pg8 {
constexpr int BM = 256, BK = 64, HALF = 128, HTB = HALF * BK * 2, STAGE_BYTES = 8 * HTB, NXCD = 8, WGM = 8;
DI int lds_byte(int r, int c) { const int st = (r >> 4) * 2 + (c >> 5), rr = r & 15, cc = c & 31, ob = rr * 64 + cc * 2; return st * 1024 + (ob ^ (((ob >> 9) & 1) << 5)); }
DI void stage_rc(int b, int& R, int& C) { const int st = b / 1024, sb = b % 1024, swz = sb ^ (((sb >> 9) & 1) << 5); R = (st >> 1) * 16 + swz / 64; C = (st & 1) * 32 + (swz % 64) / 2; }
DI int perm32(int rho) { const int n = rho >> 4, i = rho & 15; return 8 * (i >> 2) + 4 * n + (i & 3); }

struct Unit { int pm, pn, tag, nt; const char* A; const char* B; };

DI void map_tile(int L, int nM, int nN, int& pm, int& pn) {
    const int nwg = nM * nN; int wgid = L;
    { const int q = nwg / NXCD, r = nwg % NXCD, xcd = wgid % NXCD, off = wgid / NXCD; wgid = (xcd < r ? xcd * (q + 1) : r * (q + 1) + (xcd - r) * q) + off; }
    const int nig = WGM * nN, gid = wgid / nig, fm = gid * WGM, gsz = (nM - fm) < WGM ? (nM - fm) : WGM;
    pm = fm + ((wgid % nig) % gsz); pn = (wgid % nig) / gsz;
}

template <class Epi, class Sched>
DI void gemm_phase(LAS unsigned char* lds, const int lda, const int ldb, const Sched& S, const Epi& E) {
    const int tid = fresh_tid(), wid = __builtin_amdgcn_readfirstlane(tid >> 6), lane = tid & 63, wr = wid >> 2, wc = wid & 3, fr = lane & 15, fq = lane >> 4;
    unsigned voffA[2], voffB[2];
#pragma unroll
    for (int i = 0; i < 2; ++i) { int R, C; stage_rc(tid * 16 + i * 8192, R, C); const int Rb = Epi::PERM ? ((R & ~31) + perm32(R & 31)) : R;
        voffA[i] = (unsigned)(R * lda + C) * 2u; voffB[i] = (unsigned)(Rb * ldb + C) * 2u; }
    const size_t kstep = (size_t)(BK * 2);
    const size_t hstepA = (size_t)HALF * lda * 2, hstepB = (size_t)HALF * ldb * 2;
    const unsigned ldsw = (unsigned)wid * 1024u;
    const int aoff = lds_byte(wr * 64 + fr, fq * 8), boff = lds_byte(wc * 32 + fr, fq * 8);
#define PG8_SA(b, h) (((b) * 2 + (h)) * HTB)
#define PG8_SB(b, h) ((4 + (b) * 2 + (h)) * HTB)
#define PG8_STAGE(bufoff, gbase, voff) do { _Pragma("unroll") for (int _i = 0; _i < 2; ++_i) \
        __builtin_amdgcn_global_load_lds((const unsigned*)((const char*)(gbase) + (voff)[_i]), (LAS unsigned*)(lds + (bufoff) + ldsw + _i * 8192), 16, 0, 0); } while (0)
#define PG8_LDA(dst, b, h) do { _Pragma("unroll") for (int m = 0; m < 4; ++m) _Pragma("unroll") for (int k = 0; k < 2; ++k) dst[m][k] = *(const LAS bf16x8*)(lds + PG8_SA(b, h) + aoff + m * 2048 + k * 1024); } while (0)
#define PG8_LDB(dst, b, h) do { _Pragma("unroll") for (int n = 0; n < 2; ++n) _Pragma("unroll") for (int k = 0; k < 2; ++k) dst[n][k] = *(const LAS bf16x8*)(lds + PG8_SB(b, h) + boff + n * 2048 + k * 1024); } while (0)
#define PG8_MMA(ai, bj, At, Bt) do { __builtin_amdgcn_s_setprio(1); _Pragma("unroll") for (int m = 0; m < 4; ++m) _Pragma("unroll") for (int n = 0; n < 2; ++n) _Pragma("unroll") for (int k = 0; k < 2; ++k) \
        acc[ai][bj][m][n] = __builtin_amdgcn_mfma_f32_16x16x32_bf16(Bt[n][k], At[m][k], acc[ai][bj][m][n], 0, 0, 0); __builtin_amdgcn_s_setprio(0); } while (0)
#define PG8_WAIT_V(n) asm volatile("s_waitcnt vmcnt(" #n ")" ::: "memory")
#define PG8_WAIT_L(n) asm volatile("s_waitcnt lgkmcnt(" #n ")" ::: "memory")
#define PG8_BAR __builtin_amdgcn_s_barrier()
#define PG8_SCHED __builtin_amdgcn_sched_barrier(0)
    Unit cur, nxt; int ui = 0;
    if (!S.next(0, cur)) return;
    f32x4 acc[2][2][4][2];
#pragma unroll
    for (int a = 0; a < 2; ++a)
#pragma unroll
        for (int b = 0; b < 2; ++b)
#pragma unroll
            for (int m = 0; m < 4; ++m)
#pragma unroll
                for (int n = 0; n < 2; ++n) acc[a][b][m][n] = (f32x4){0.f, 0.f, 0.f, 0.f};
    bf16x8 At[4][2], B0[2][2], B1[2][2];
    const char* cA = cur.A; const char* cB = cur.B;
    PG8_STAGE(PG8_SB(0, 0), cB, voffB); PG8_STAGE(PG8_SA(0, 0), cA, voffA); PG8_STAGE(PG8_SB(0, 1), cB + hstepB, voffB); PG8_STAGE(PG8_SA(0, 1), cA + hstepA, voffA);
    if (wr == 1) PG8_BAR;
    PG8_WAIT_V(4); PG8_BAR;
    PG8_STAGE(PG8_SB(1, 0), cB + kstep, voffB); PG8_STAGE(PG8_SA(1, 0), cA + kstep, voffA); PG8_STAGE(PG8_SB(1, 1), cB + hstepB + kstep, voffB);
    PG8_WAIT_V(6); PG8_BAR;
    for (;;) {
        const bool has_next = S.next(ui + 1, nxt);
        const char* nA = has_next ? nxt.A : cA; const char* nB = has_next ? nxt.B : cB;
        const int nt = cur.nt;
        for (int t = 0; t < nt; t += 2) {
            const bool last = (t == nt - 2);
            const char* a1 = cA + (size_t)(t + 1) * kstep;
            const char* a2 = last ? nA : cA + (size_t)(t + 2) * kstep; const char* b2 = last ? nB : cB + (size_t)(t + 2) * kstep;
            const char* a3 = a2 + kstep; const char* b3 = b2 + kstep;
            PG8_LDB(B0, 0, 0); PG8_SCHED; PG8_LDA(At, 0, 0); PG8_STAGE(PG8_SA(1, 1), a1 + hstepA, voffA);
            PG8_WAIT_L(8); PG8_BAR; PG8_WAIT_L(0); PG8_MMA(0, 0, At, B0); PG8_BAR; PG8_SCHED;
            PG8_LDB(B1, 0, 1); PG8_STAGE(PG8_SB(0, 0), b2, voffB);
            PG8_BAR; PG8_WAIT_L(0); PG8_MMA(0, 1, At, B1); PG8_BAR;
            PG8_LDA(At, 0, 1); PG8_STAGE(PG8_SA(0, 0), a2, voffA);
            PG8_BAR; PG8_WAIT_L(0); PG8_MMA(1, 0, At, B0); PG8_BAR; PG8_SCHED;
            PG8_STAGE(PG8_SB(0, 1), b2 + hstepB, voffB);
            PG8_WAIT_V(6); PG8_BAR; PG8_MMA(1, 1, At, B1); PG8_BAR;
            PG8_LDB(B0, 1, 0); PG8_SCHED; PG8_LDA(At, 1, 0); PG8_STAGE(PG8_SA(0, 1), a2 + hstepA, voffA);
            PG8_WAIT_L(8); PG8_BAR; PG8_WAIT_L(0); PG8_MMA(0, 0, At, B0); PG8_BAR; PG8_SCHED;
            PG8_LDB(B1, 1, 1); PG8_STAGE(PG8_SB(1, 0), b3, voffB);
            PG8_BAR; PG8_WAIT_L(0); PG8_MMA(0, 1, At, B1); PG8_BAR;
            PG8_LDA(At, 1, 1); PG8_STAGE(PG8_SA(1, 0), a3, voffA);
            PG8_BAR; PG8_WAIT_L(0); PG8_MMA(1, 0, At, B0); PG8_BAR; PG8_SCHED;
            PG8_STAGE(PG8_SB(1, 1), b3 + hstepB, voffB);
            PG8_WAIT_V(6); PG8_BAR; PG8_MMA(1, 1, At, B1); PG8_BAR;
        }
        E(acc, cur, wr, wc, fr, fq);
        if (!has_next) break;
#pragma unroll
        for (int a = 0; a < 2; ++a)
#pragma unroll
            for (int b = 0; b < 2; ++b)
#pragma unroll
                for (int m = 0; m < 4; ++m)
#pragma unroll
                    for (int n = 0; n < 2; ++n) acc[a][b][m][n] = (f32x4){0.f, 0.f, 0.f, 0.f};
        cur = nxt; cA = nA; cB = nB; ++ui;
    }
    PG8_WAIT_V(0);
    if (wr == 0) PG8_BAR;
    PG8_BAR;
#undef PG8_SA
#undef PG8_SB
#undef PG8_STAGE
#undef PG8_LDA
#undef PG8_LDB
#undef PG8_MMA
#undef PG8_WAIT_V
#undef PG8_WAIT_L
#undef PG8_BAR
#undef PG8_SCHED
}
}

struct Sched1 {
    const char* A; const char* B; int G, c;
    DI bool next(int i, pg8::Unit& u) const {
        const int L = i * G + c; if (L >= 64 * 67) return false;
        pg8::map_tile(L, 64, 67, u.pm, u.pn); u.tag = 0; u.nt = 32;
        u.A = A + (size_t)u.pm * 256 * 4096 * 2; u.B = B + (size_t)u.pn * 256 * 2048 * 2; return true;
    }
};
struct Epi1 {
    static constexpr bool PERM = true;
    bf16_t* qkva; bf16_t* hoa; bf16_t* dqkv; bf16_t* dz; float* beta; float* g; const float* b_qkv; const float* a_log; const float* dt_bias;
    DI void operator()(const f32x4 (&acc)[2][2][4][2], const pg8::Unit& u, int wr, int wc, int fr, int fq) const {
        const int pn = u.pn;
        const int row0 = u.pm * 256 + wr * 64 + fr;
        const int cl0 = wc * 32 + 8 * fq;
        if (pn == 66) {
            if (wc < 2) {
                const int hc = 8 * fq;
#pragma unroll
                for (int ai = 0; ai < 2; ++ai)
#pragma unroll
                    for (int m = 0; m < 4; ++m) {
                        const int row = row0 + ai * 128 + m * 16;
                        f32x4 v0 = acc[ai][0][m][0], v1 = acc[ai][0][m][1], o0, o1;
                        if (wc == 0) {
#pragma unroll
                            for (int j = 0; j < 4; ++j) { o0[j] = sigmoidf_(v0[j]); o1[j] = sigmoidf_(v1[j]); }
                            *(f32x4*)(beta + (size_t)row * 32 + hc) = o0; *(f32x4*)(beta + (size_t)row * 32 + hc + 4) = o1;
                        } else {
#pragma unroll
                            for (int j = 0; j < 4; ++j) {
                                float p0 = v0[j] + dt_bias[hc + j], p1 = v1[j] + dt_bias[hc + 4 + j];
                                float s0 = fmaxf(p0, 0.f) + log1pf(__expf(-fabsf(p0))), s1 = fmaxf(p1, 0.f) + log1pf(__expf(-fabsf(p1)));
                                o0[j] = -__expf(a_log[hc + j]) * s0; o1[j] = -__expf(a_log[hc + 4 + j]) * s1;
                            }
                            *(f32x4*)(g + (size_t)row * 32 + hc) = o0; *(f32x4*)(g + (size_t)row * 32 + hc + 4) = o1;
                        }
                    }
            }
            return;
        }
        bf16_t* base; int ld, colt, mode;
        if (pn < 10) { base = qkva; ld = 2560; colt = pn * 256; mode = 0; }
        else if (pn < 18) { base = hoa + 2048; ld = 4096; colt = (pn - 10) * 256; mode = 1; }
        else if (pn < 50) { base = dqkv; ld = 8192; colt = (pn - 18) * 256; mode = 2; }
        else { base = dz; ld = 4096; colt = (pn - 50) * 256; mode = 1; }
#pragma unroll
        for (int bj = 0; bj < 2; ++bj) {
            const int col = colt + bj * 128 + cl0;
            f32x4 b0 = (f32x4){0.f, 0.f, 0.f, 0.f}, b1 = b0;
            if (mode == 0) { b0 = *(const f32x4*)(b_qkv + col); b1 = *(const f32x4*)(b_qkv + col + 4); }
#pragma unroll
            for (int ai = 0; ai < 2; ++ai)
#pragma unroll
                for (int m = 0; m < 4; ++m) {
                    const int row = row0 + ai * 128 + m * 16;
                    f32x4 v0 = acc[ai][bj][m][0] + b0, v1 = acc[ai][bj][m][1] + b1;
                    u32x4 w; w.x = pk_bf16(v0[0], v0[1]); w.y = pk_bf16(v0[2], v0[3]); w.z = pk_bf16(v1[0], v1[1]); w.w = pk_bf16(v1[2], v1[3]);
                    *(u32x4*)(base + (size_t)row * ld + col) = w;
                }
        }
    }
};

struct Sched2 {
    const char* hoa; const char* od; const char* w2a; const char* w2b; const char* wdn; int G, c;
    DI bool next(int i, pg8::Unit& u) const {
        const int L = (i >> 2) * G + c; if (L >= 64 * 8) return false;
        pg8::map_tile(L, 64, 8, u.pm, u.pn); const int sub = i & 3; u.tag = sub;
        const size_t ao = (size_t)u.pm * 256 * 4096 * 2, bo = (size_t)u.pn * 256 * 4096 * 2;
        if (sub == 0) { u.A = hoa + ao; u.B = w2b + bo; u.nt = 32; }
        else if (sub == 1) { u.A = od + ao; u.B = wdn + bo; u.nt = 64; }
        else if (sub == 2) { u.A = hoa + ao; u.B = w2a + bo; u.nt = 32; }
        else { u.A = hoa + ao + 4096; u.B = w2a + bo + 4096; u.nt = 32; }
        return true;
    }
};
struct Epi2 {
    static constexpr bool PERM = true;
    bf16_t* merged; unsigned char* scr;
    DI void operator()(const f32x4 (&acc)[2][2][4][2], const pg8::Unit& u, int wr, int wc, int fr, int fq) const {
        const int tag = u.tag;
        const int row0 = u.pm * 256 + wr * 64 + fr, col0 = u.pn * 256 + wc * 32 + 8 * fq;
        unsigned char* __restrict__ const sbase = scr + (size_t)threadIdx.x * 16;
        bf16_t* __restrict__ const mbase = merged + (size_t)row0 * 2048 + col0;
        if ((tag & 1) == 0) {
#pragma unroll
            for (int ai = 0; ai < 2; ++ai)
#pragma unroll
                for (int m = 0; m < 4; ++m)
#pragma unroll
                    for (int bj = 0; bj < 2; ++bj) {
                        f32x4 v0 = acc[ai][bj][m][0], v1 = acc[ai][bj][m][1];
#pragma unroll
                        for (int j = 0; j < 4; ++j) { v0[j] = sigmoidf_(v0[j]); v1[j] = sigmoidf_(v1[j]); }
                        u32x4 w; w.x = pk_bf16(v0[0], v0[1]); w.y = pk_bf16(v0[2], v0[3]); w.z = pk_bf16(v1[0], v1[1]); w.w = pk_bf16(v1[2], v1[3]);
                        *(u32x4*)(sbase + (size_t)((ai * 4 + m) * 2 + bj) * 8192) = w;
                    }
            return;
        }
        asm volatile("s_waitcnt vmcnt(0)" ::: "memory");
#pragma unroll
        for (int aq = 0; aq < 4; ++aq) {
            const int ai = aq >> 1, m0 = (aq & 1) * 2;
            u32x4 gt[4][2], pv[4][2];
#pragma unroll
            for (int m = m0; m < m0 + 2; ++m)
#pragma unroll
                for (int bj = 0; bj < 2; ++bj) {
                    gt[m][bj] = *(const u32x4*)(sbase + (size_t)((ai * 4 + m) * 2 + bj) * 8192);
                    pv[m][bj] = (tag == 3) ? *(const u32x4*)(mbase + (size_t)(ai * 128 + m * 16) * 2048 + bj * 128) : (u32x4){0u, 0u, 0u, 0u};
                }
#pragma unroll
            for (int m = m0; m < m0 + 2; ++m)
#pragma unroll
                for (int bj = 0; bj < 2; ++bj) {
                    const f32x4 v0 = acc[ai][bj][m][0], v1 = acc[ai][bj][m][1];
                    const u32x4 g4 = gt[m][bj], p4 = pv[m][bj];
                    float o[8];
                    o[0] = bflo(g4.x) * v0[0] + bflo(p4.x); o[1] = bfhi(g4.x) * v0[1] + bfhi(p4.x); o[2] = bflo(g4.y) * v0[2] + bflo(p4.y); o[3] = bfhi(g4.y) * v0[3] + bfhi(p4.y);
                    o[4] = bflo(g4.z) * v1[0] + bflo(p4.z); o[5] = bfhi(g4.z) * v1[1] + bfhi(p4.z); o[6] = bflo(g4.w) * v1[2] + bflo(p4.w); o[7] = bfhi(g4.w) * v1[3] + bfhi(p4.w);
                    u32x4 w; w.x = pk_bf16(o[0], o[1]); w.y = pk_bf16(o[2], o[3]); w.z = pk_bf16(o[4], o[5]); w.w = pk_bf16(o[6], o[7]);
                    *(u32x4*)(mbase + (size_t)(ai * 128 + m * 16) * 2048 + bj * 128) = w;
                }
        }
    }
};

struct Sched3 {
    const char* A; const char* B; int G, c;
    DI bool next(int i, pg8::Unit& u) const {
        const int L = i * G + c; if (L >= 64 * 8) return false;
        pg8::map_tile(L, 64, 8, u.pm, u.pn); u.tag = 0; u.nt = 32;
        u.A = A + (size_t)u.pm * 256 * 2048 * 2; u.B = B + (size_t)u.pn * 256 * 2048 * 2; return true;
    }
};
struct Epi3 {
    static constexpr bool PERM = false;
    const float* x; float* out; float* part;
    DI void operator()(const f32x4 (&acc)[2][2][4][2], const pg8::Unit& u, int wr, int wc, int fr, int fq) const {
        const int row0 = u.pm * 256 + wr * 64 + fr, col0 = u.pn * 256 + wc * 32 + 4 * fq;
        const float* __restrict__ const xb = x + (size_t)row0 * 2048 + col0;
        float* __restrict__ const ob = out + (size_t)row0 * 2048 + col0;
#pragma unroll
        for (int aq = 0; aq < 4; ++aq) {
            const int ai = aq >> 1, m0 = (aq & 1) * 2;
            f32x4 xs[4][2][2];
#pragma unroll
            for (int m = m0; m < m0 + 2; ++m)
#pragma unroll
                for (int bj = 0; bj < 2; ++bj)
#pragma unroll
                    for (int n = 0; n < 2; ++n) xs[m][bj][n] = *(const f32x4*)(xb + (size_t)(ai * 128 + m * 16) * 2048 + bj * 128 + n * 16);
#pragma unroll
            for (int m = m0; m < m0 + 2; ++m) {
                const int row = row0 + ai * 128 + m * 16;
                float ss = 0.f;
#pragma unroll
                for (int bj = 0; bj < 2; ++bj)
#pragma unroll
                    for (int n = 0; n < 2; ++n) {
                        const f32x4 v = acc[ai][bj][m][n] + xs[m][bj][n];
                        *(f32x4*)(ob + (size_t)(ai * 128 + m * 16) * 2048 + bj * 128 + n * 16) = v;
                        ss += v[0] * v[0] + v[1] * v[1] + v[2] * v[2] + v[3] * v[3];
                    }
                ss += __shfl_xor(ss, 16); ss += __shfl_xor(ss, 32);
                if (fq == 0) part[(size_t)row * 32 + u.pn * 4 + wc] = ss;
            }
        }
    }
};

struct TDesc { const float* src; bf16_t* dst; int lds, ldd; };
DI TDesc tile_desc(const Params& P, int t) {
    bf16_t* win_t = (bf16_t*)(P.ws + WS_WIN_T); bf16_t* w2a = (bf16_t*)(P.ws + WS_W2A_T); bf16_t* w2b = (bf16_t*)(P.ws + WS_W2B_T);
    bf16_t* wdn = (bf16_t*)(P.ws + WS_WDN_T); bf16_t* wout = (bf16_t*)(P.ws + WS_WOUT_T);
    constexpr int T_IN = 329 * 32, T_ATT = 1024, T_DN = 2048;
    TDesc d;
    if (t < T_IN) {
        const int nt = t >> 5, kt = t & 31; const int col = nt * 64;
        d.src = P.w_in + (size_t)(kt * 64) * 21056 + col; d.lds = 21056;
        if (col < 16960) { d.dst = win_t + (size_t)col * 2048 + kt * 64; d.ldd = 2048; }
        else if (col < 16960 + 2048) { d.dst = w2a + (size_t)(col - 16960) * 4096 + kt * 64; d.ldd = 4096; }
        else { d.dst = w2b + (size_t)(col - 16960 - 2048) * 4096 + kt * 64; d.ldd = 4096; }
    } else if (t < T_IN + T_ATT) {
        const int q = t - T_IN; const int nt = q >> 5, kt = q & 31;
        d.src = P.w_att + (size_t)(kt * 64) * 2048 + nt * 64; d.lds = 2048; d.dst = w2a + (size_t)(nt * 64) * 4096 + 2048 + kt * 64; d.ldd = 4096;
    } else if (t < T_IN + T_ATT + T_DN) {
        const int q = t - T_IN - T_ATT; const int nt = q >> 6, kt = q & 63;
        d.src = P.w_dn + (size_t)(kt * 64) * 2048 + nt * 64; d.lds = 2048; d.dst = wdn + (size_t)(nt * 64) * 4096 + kt * 64; d.ldd = 4096;
    } else {
        const int q = t - T_IN - T_ATT - T_DN; const int nt = q >> 5, kt = q & 31;
        d.src = P.w_out + (size_t)(kt * 64) * 2048 + nt * 64; d.lds = 2048; d.dst = wout + (size_t)(nt * 64) * 2048 + kt * 64; d.ldd = 2048;
    }
    return d;
}

DI void phase_prologue(const Params& P, LAS unsigned char* L, int tid, int wave, int lane) {
    LAS float* tile = (LAS float*)L;
    bf16_t* win_t = (bf16_t*)(P.ws + WS_WIN_T);
    constexpr int T_ALL = 329 * 32 + 1024 + 2048 + 1024;
    {
        const int r0 = tid >> 4, c4 = (tid & 15) * 4, n = tid >> 3, kc = (tid & 7) * 8;
        int t = blockIdx.x;
        f32x4 v0 = (f32x4){0.f, 0.f, 0.f, 0.f}, v1 = v0;
        TDesc d{};
        if (t < T_ALL) { d = tile_desc(P, t); v0 = *(const f32x4*)(d.src + (size_t)r0 * d.lds + c4); v1 = *(const f32x4*)(d.src + (size_t)(r0 + 32) * d.lds + c4); }
        while (t < T_ALL) {
            tile[r0 * 65 + c4 + 0] = v0[0]; tile[r0 * 65 + c4 + 1] = v0[1]; tile[r0 * 65 + c4 + 2] = v0[2]; tile[r0 * 65 + c4 + 3] = v0[3];
            tile[(r0 + 32) * 65 + c4 + 0] = v1[0]; tile[(r0 + 32) * 65 + c4 + 1] = v1[1]; tile[(r0 + 32) * 65 + c4 + 2] = v1[2]; tile[(r0 + 32) * 65 + c4 + 3] = v1[3];
            lds_barrier();
            const TDesc cur = d;
            t += gridDim.x;
            if (t < T_ALL) { d = tile_desc(P, t); v0 = *(const f32x4*)(d.src + (size_t)r0 * d.lds + c4); v1 = *(const f32x4*)(d.src + (size_t)(r0 + 32) * d.lds + c4); }
            float f[8];
#pragma unroll
            for (int e = 0; e < 8; ++e) f[e] = tile[(kc + e) * 65 + n];
            u32x4 w; w.x = pk_bf16(f[0], f[1]); w.y = pk_bf16(f[2], f[3]); w.z = pk_bf16(f[4], f[5]); w.w = pk_bf16(f[6], f[7]);
            *(u32x4*)(cur.dst + (size_t)n * cur.ldd + kc) = w;
            lds_barrier();
        }
    }
    {
        u32x4* z = (u32x4*)(win_t + (size_t)16960 * 2048);
        for (int i = blockIdx.x * 512 + tid; i < 192 * 2048 / 8; i += gridDim.x * 512) z[i] = (u32x4){0u, 0u, 0u, 0u};
    }
    bf16_t* hoa = (bf16_t*)P.out;
    f32x4 nw[8];
#pragma unroll
    for (int i = 0; i < 8; ++i) nw[i] = *(const f32x4*)(P.norm_w + (i * 64 + lane) * 4);
    for (int row = blockIdx.x * 8 + wave; row < MTOK; row += gridDim.x * 16) {
        const int row2 = row + gridDim.x * 8; const bool has2 = row2 < MTOK;
        const float* xr = P.x + (size_t)row * 2048; const float* xr2 = P.x + (size_t)(has2 ? row2 : row) * 2048;
        f32x4 v[8], u[8]; float ss = 0.f, ss2 = 0.f;
#pragma unroll
        for (int i = 0; i < 8; ++i) { v[i] = *(const f32x4*)(xr + (i * 64 + lane) * 4); u[i] = *(const f32x4*)(xr2 + (i * 64 + lane) * 4); }
#pragma unroll
        for (int i = 0; i < 8; ++i) {
            ss += v[i][0] * v[i][0] + v[i][1] * v[i][1] + v[i][2] * v[i][2] + v[i][3] * v[i][3];
            ss2 += u[i][0] * u[i][0] + u[i][1] * u[i][1] + u[i][2] * u[i][2] + u[i][3] * u[i][3];
        }
#pragma unroll
        for (int d = 1; d < 64; d <<= 1) { ss += __shfl_xor(ss, d); ss2 += __shfl_xor(ss2, d); }
        const float rs = rsqrtf(ss * (1.f / 2048.f) + 1e-6f), rs2 = rsqrtf(ss2 * (1.f / 2048.f) + 1e-6f);
#pragma unroll
        for (int i = 0; i < 8; ++i) {
            const f32x4 w = nw[i];
            u32x2 o; o.x = pk_bf16(v[i][0] * rs * w[0], v[i][1] * rs * w[1]); o.y = pk_bf16(v[i][2] * rs * w[2], v[i][3] * rs * w[3]);
            *(u32x2*)(hoa + (size_t)row * 4096 + (i * 64 + lane) * 4) = o;
            if (has2) {
                u32x2 o2; o2.x = pk_bf16(u[i][0] * rs2 * w[0], u[i][1] * rs2 * w[1]); o2.y = pk_bf16(u[i][2] * rs2 * w[2], u[i][3] * rs2 * w[3]);
                *(u32x2*)(hoa + (size_t)row2 * 4096 + (i * 64 + lane) * 4) = o2;
            }
        }
    }
}

constexpr int A_KA = 0, A_VT = 27648;
DI void attn_item(const Params& P, LAS unsigned char* L, int item, int tid, int wave, int lane, int dry = 0) {
    const int tb = item & 31, kvh = (item >> 5) & 3, b = item >> 7;
    const int t0 = tb * 64, l15 = lane & 15, g = lane >> 4;
    const bf16_t* qkv = (const bf16_t*)(P.ws + WS_QKVA) + (size_t)b * SEQ * 2560;
    bf16_t* hoa = (bf16_t*)P.out;
#pragma unroll
    for (int i = 0; i < 3; ++i) {
        const int id = tid + 512 * i, row = id >> 3, dc = id & 7, tok = t0 - 128 + row;
        u32x4 kv = (u32x4){0u, 0u, 0u, 0u}, vv = kv;
        if (tok >= 0) { const bf16_t* p = qkv + (size_t)tok * 2560 + 2048 + kvh * 64 + dc * 8; kv = *(const u32x4*)p; vv = *(const u32x4*)(p + 256); }
        *(LAS u32x4*)(L + A_KA + row * 144 + dc * 16) = kv;
#pragma unroll
        for (int e = 0; e < 8; ++e) {
            const unsigned wv = vv[e >> 1]; const unsigned short val = (unsigned short)((e & 1) ? (wv >> 16) : (wv & 0xffffu));
            *(LAS unsigned short*)(L + A_VT + (dc * 8 + e) * 400 + row * 2) = val;
        }
    }
    lds_barrier();
    const int head = kvh * 8 + wave;
    const float sink = P.sinks[head];
    const int A_OT = 53248 + wave * 2304;
    const int otok = lane >> 2, och = lane & 3;
    for (int a = 0; a < 4; ++a) {
        const bf16_t* qp = qkv + (size_t)(t0 + 16 * a + l15) * 2560 + head * 64 + 8 * g;
        const bf16x8 q0 = *(const bf16x8*)qp, q1 = *(const bf16x8*)(qp + 32);
        bf16_t* zp = hoa + (size_t)(b * SEQ + t0 + 16 * a + otok) * 4096 + 2048 + head * 64 + 16 * och;
        const u32x4 zz0 = *(const u32x4*)zp, zz1 = *(const u32x4*)(zp + 8);
        f32x4 s[9];
#pragma unroll
        for (int i = 0; i < 9; ++i) {
            const int ko = A_KA + (16 * (a + i) + l15) * 144 + 16 * g;
            f32x4 z = (f32x4){0.f, 0.f, 0.f, 0.f};
            z = mfma32(lds16(L, ko), q0, z); z = mfma32(lds16(L, ko + 64), q1, z); s[i] = z;
        }
        const int qi = 16 * a + l15;
        float m = -INFINITY;
#pragma unroll
        for (int i = 0; i < 9; ++i)
#pragma unroll
            for (int j = 0; j < 4; ++j) {
                const int kk = 16 * (a + i) + 4 * g + j;
                const bool valid = (kk > qi) && (kk <= qi + 128) && (t0 - 128 + kk >= 0);
                const float sv = valid ? s[i][j] * 0.125f : -INFINITY;
                s[i][j] = sv; m = fmaxf(m, sv);
            }
        m = fmaxf(m, __shfl_xor(m, 16)); m = fmaxf(m, __shfl_xor(m, 32)); m = fmaxf(m, sink);
        float sum = 0.f;
#pragma unroll
        for (int i = 0; i < 9; ++i)
#pragma unroll
            for (int j = 0; j < 4; ++j) { const float p = __expf(s[i][j] - m); s[i][j] = p; sum += p; }
        sum += __shfl_xor(sum, 16); sum += __shfl_xor(sum, 32);
        const float inv = 1.f / (sum + __expf(sink - m));
        f32x4 o[4];
#pragma unroll
        for (int dt = 0; dt < 4; ++dt) o[dt] = (f32x4){0.f, 0.f, 0.f, 0.f};
#pragma unroll
        for (int i = 0; i < 9; ++i) {
            const bf16x4 pa = pack4(s[i][0] * inv, s[i][1] * inv, s[i][2] * inv, s[i][3] * inv);
#pragma unroll
            for (int dt = 0; dt < 4; ++dt) o[dt] = mfma16(pa, lds8(L, A_VT + (16 * dt + l15) * 400 + (16 * (a + i) + 4 * g) * 2), o[dt]);
        }
#pragma unroll
        for (int j = 0; j < 4; ++j)
#pragma unroll
            for (int dt = 0; dt < 4; ++dt)
                *(LAS unsigned short*)(L + A_OT + (4 * g + j) * 144 + (16 * dt + l15) * 2) = (unsigned short)(pk_bf16(o[dt][j], 0.f) & 0xffffu);
        asm volatile("s_waitcnt lgkmcnt(0)" ::: "memory");
        {
            const u32x4 o0 = *(const LAS u32x4*)(L + A_OT + otok * 144 + och * 32), o1 = *(const LAS u32x4*)(L + A_OT + otok * 144 + och * 32 + 16);
            u32x4 w0, w1;
#pragma unroll
            for (int e = 0; e < 4; ++e) {
                w0[e] = pk_bf16(bflo(o0[e]) * siluf_(bflo(zz0[e])), bfhi(o0[e]) * siluf_(bfhi(zz0[e])));
                w1[e] = pk_bf16(bflo(o1[e]) * siluf_(bflo(zz1[e])), bfhi(o1[e]) * siluf_(bfhi(zz1[e])));
            }
            bf16_t* op = dry ? ((bf16_t*)(P.ws + WS_WIN_T) + ((size_t)(zp - hoa) & 0x1fffff0u)) : zp;
            *(u32x4*)op = w0; *(u32x4*)(op + 8) = w1;
        }
        asm volatile("s_waitcnt lgkmcnt(0)" ::: "memory");
    }
    lds_barrier();
}

constexpr int D_QS = 0, D_KS = 17408, D_WL = 34816, D_VS = 52224, D_AB = 70656, D_MT = 79872, D_TB = 89088, D_TBG = 98304, D_QKM = 107520,
              D_XB = 116736, D_YB = 125952, D_YTB = 135168, D_GC = 144384, D_BETA = 144640, D_EG = 144896, D_RED = 145152, D_CW = 147200;
static_assert(D_CW + 6144 <= LDS_BYTES, "lds");

template <bool DO_X, bool DO_Y, bool DO_YROW>
DI void neu_step(LAS unsigned char* L, int xin, int yin, int ytin, int xout, int yout, int ytout, f32x4& xacc, int ti, int tj, int blk, int l15, int g) {
    const int ra = (16 * ti + l15) * 144 + 16 * g + blk * 64, rb = (16 * tj + l15) * 144 + 16 * g + blk * 64;
    const int wo = (16 * tj + l15) * 144 + (16 * ti + 4 * g) * 2;
    const f32x4 z = (f32x4){0.f, 0.f, 0.f, 0.f};
    const bf16x8 yta = lds16(L, ytin + ra);
    if (DO_Y) {
        const f32x4 y = mfma32(lds16(L, yin + ra), lds16(L, ytin + rb), z);
        st8(L, ytout + wo, pack4(y[0], y[1], y[2], y[3]));
        if (DO_YROW) {
            const f32x4 yt = mfma32(yta, lds16(L, yin + rb), z);
            st8(L, yout + wo, pack4(yt[0], yt[1], yt[2], yt[3]));
        }
    }
    if (DO_X) {
        const f32x4 x = mfma32(yta, lds16(L, xin + rb), xacc);
        xacc = x;
        st8(L, xout + wo, pack4(x[0], x[1], x[2], x[3]));
    }
}

DI void deltanet_seq(const Params& P, LAS unsigned char* L, int seq, int tid, int wave, int lane, int dry = 0) {
    const int vh = seq & 31, b = seq >> 5, kh = vh >> 1;
    const int l15 = lane & 15, g = lane >> 4;
    const bf16_t* dqkv = (const bf16_t*)(P.ws + WS_DQKV) + (size_t)b * SEQ * 8192;
    bf16_t* dz = (bf16_t*)(P.ws + WS_DZ) + (size_t)b * SEQ * 4096 + vh * 128;
    const float* garr = (const float*)(P.ws + WS_G) + (size_t)b * SEQ * 32 + vh;
    const float* barr = (const float*)(P.ws + WS_BETA) + (size_t)b * SEQ * 32 + vh;
    LAS float* GC = (LAS float*)(L + D_GC); LAS float* BETA = (LAS float*)(L + D_BETA); LAS float* EG = (LAS float*)(L + D_EG);
    LAS float* RED = (LAS float*)(L + D_RED); LAS float* CW = (LAS float*)(L + D_CW);
    const int cbq = kh * 128, cbk = 2048 + kh * 128, cbv = 4096 + vh * 128;
    for (int i = tid; i < 1536; i += 512) { const int X = i >> 9, tap = (i >> 7) & 3, ch = i & 127; const int cb = X == 0 ? cbq : (X == 1 ? cbk : cbv); CW[i] = P.conv_w[(size_t)tap * 8192 + cb + ch]; }
    const float dnw = P.dn_norm_w[16 * wave + l15];
    f32x4 Sacc[8];
#pragma unroll
    for (int i = 0; i < 8; ++i) Sacc[i] = (f32x4){0.f, 0.f, 0.f, 0.f};
    lds_barrier();

    LAS unsigned char* const L0 = L;
    for (int n = 0; n < 32; ++n) {
        const int t0 = n * 64;
        int lz = 0; asm volatile("" : "+v"(lz));
        LAS unsigned char* const L = L0 + lz;
        LAS float* GC = (LAS float*)(L + D_GC); LAS float* BETA = (LAS float*)(L + D_BETA); LAS float* EG = (LAS float*)(L + D_EG);
        LAS float* RED = (LAS float*)(L + D_RED); LAS float* CW = (LAS float*)(L + D_CW);
        {
            asm volatile("" ::: "memory");
            const int grp = tid & 15, tokb = tid >> 4;
            const int c0 = 2 * tokb;
#pragma unroll 1
            for (int X = 0; X < 3; ++X) {
                const int cb = (X == 0 ? cbq : (X == 1 ? cbk : cbv)) + grp * 8;
                u32x4 rawr[5];
#pragma unroll
                for (int r = 0; r < 5; ++r) { const int tt = t0 + c0 - 3 + r; rawr[r] = (tt >= 0) ? *(const u32x4*)(dqkv + (size_t)tt * 8192 + cb) : (u32x4){0u, 0u, 0u, 0u}; }
                float accA[8], accB[8];
#pragma unroll
                for (int e = 0; e < 8; ++e) { accA[e] = 0.f; accB[e] = 0.f; }
#pragma unroll
                for (int tap = 0; tap < 4; ++tap) {
                    const f32x4 w0 = *(const LAS f32x4*)(CW + (X * 4 + tap) * 128 + grp * 8), w1 = *(const LAS f32x4*)(CW + (X * 4 + tap) * 128 + grp * 8 + 4);
                    const u32x4 u = rawr[tap], v = rawr[tap + 1];
                    accA[0] += w0[0] * bflo(u.x); accA[1] += w0[1] * bfhi(u.x); accA[2] += w0[2] * bflo(u.y); accA[3] += w0[3] * bfhi(u.y);
                    accA[4] += w1[0] * bflo(u.z); accA[5] += w1[1] * bfhi(u.z); accA[6] += w1[2] * bflo(u.w); accA[7] += w1[3] * bfhi(u.w);
                    accB[0] += w0[0] * bflo(v.x); accB[1] += w0[1] * bfhi(v.x); accB[2] += w0[2] * bflo(v.y); accB[3] += w0[3] * bfhi(v.y);
                    accB[4] += w1[0] * bflo(v.z); accB[5] += w1[1] * bfhi(v.z); accB[6] += w1[2] * bflo(v.w); accB[7] += w1[3] * bfhi(v.w);
                }
                float ssA = 0.f, ssB = 0.f;
#pragma unroll
                for (int e = 0; e < 8; ++e) { accA[e] = siluf_(accA[e]); ssA += accA[e] * accA[e]; accB[e] = siluf_(accB[e]); ssB += accB[e] * accB[e]; }
                if (X < 2) {
                    ssA = sum16(ssA); ssB = sum16(ssB);
                    const float sc = (X == 0 ? 0.08838834764831845f : 1.f);
                    const float rA = rsqrtf(ssA + 1e-6f) * sc, rB = rsqrtf(ssB + 1e-6f) * sc;
#pragma unroll
                    for (int e = 0; e < 8; ++e) { accA[e] *= rA; accB[e] *= rB; }
                }
                u32x4 wA, wB;
                wA.x = pk_bf16(accA[0], accA[1]); wA.y = pk_bf16(accA[2], accA[3]); wA.z = pk_bf16(accA[4], accA[5]); wA.w = pk_bf16(accA[6], accA[7]);
                wB.x = pk_bf16(accB[0], accB[1]); wB.y = pk_bf16(accB[2], accB[3]); wB.z = pk_bf16(accB[4], accB[5]); wB.w = pk_bf16(accB[6], accB[7]);
                const int base = (X == 0 ? D_QS : (X == 1 ? D_KS : D_VS)) + c0 * 272 + grp * 16;
                *(LAS u32x4*)(L + base) = wA; *(LAS u32x4*)(L + base + 272) = wB;
            }
            if (wave == 0) {
                float gv = garr[(size_t)(t0 + lane) * 32];
#pragma unroll
                for (int d = 1; d < 64; d <<= 1) { const float o = __shfl_up(gv, d); if (lane >= d) gv += o; }
                GC[lane] = gv; EG[lane] = __expf(gv); BETA[lane] = barr[(size_t)(t0 + lane) * 32];
            }
        }
        lds_barrier();
        const int blk = wave >> 2, ti0 = 2 * blk + ((wave >> 1) & 1), tj0 = 2 * blk + (wave & 1), tj1 = 2 * (1 - blk) + (wave & 1);
        f32x4 xacc;
        {
#pragma unroll
        for (int tt = 0; tt < 2; ++tt) {
            const int ti = ti0, tj = tt ? tj1 : tj0;
            const int ra = D_KS + (16 * ti + l15) * 272 + 16 * g, rb = D_KS + (16 * tj + l15) * 272 + 16 * g, rq = D_QS + (16 * tj + l15) * 272 + 16 * g;
            f32x4 kk = (f32x4){0.f, 0.f, 0.f, 0.f}, qk = kk;
#pragma unroll
            for (int ks = 0; ks < 4; ++ks) {
                const bf16x8 ka = lds16(L, ra + ks * 64);
                kk = mfma32(ka, lds16(L, rb + ks * 64), kk);
                qk = mfma32(ka, lds16(L, rq + ks * 64), qk);
            }
            const int c = 16 * tj + l15; const float gc_c = GC[c], be_c = BETA[c];
            float xa[4], ya[4], yta[4], qm[4];
#pragma unroll
            for (int j = 0; j < 4; ++j) {
                const int r = 16 * ti + 4 * g + j; const float gc_r = GC[r], be_r = BETA[r];
                const float dcr = __expf(fminf(gc_c - gc_r, 0.f)), drc = __expf(fminf(gc_r - gc_c, 0.f));
                const float a_cr = (c > r) ? be_c * kk[j] * dcr : 0.f;
                const float a_rc = (r > c) ? be_r * kk[j] * drc : 0.f;
                xa[j] = ((c == r) ? 1.f : 0.f) - a_cr; ya[j] = a_cr; yta[j] = a_rc;
                qm[j] = (c >= r) ? qk[j] * dcr : 0.f;
            }
            if (tt == 0) xacc = (f32x4){xa[0], xa[1], xa[2], xa[3]};
            const int wo = (16 * tj + l15) * 144 + (16 * ti + 4 * g) * 2;
            st8(L, D_XB + wo, pack4(xa[0], xa[1], xa[2], xa[3]));
            st8(L, D_YB + wo, pack4(ya[0], ya[1], ya[2], ya[3]));
            st8(L, D_AB + wo, pack4(ya[0], ya[1], ya[2], ya[3]));
            st8(L, D_YTB + wo, pack4(yta[0], yta[1], yta[2], yta[3]));
            st8(L, D_QKM + wo, pack4(qm[0], qm[1], qm[2], qm[3]));
        }
        lds_barrier();
        neu_step<false, true, true>(L, 0, D_YB, D_YTB, 0, D_TBG, D_WL, xacc, ti0, tj0, blk, l15, g);
        lds_barrier();
        neu_step<true, true, true>(L, D_XB, D_TBG, D_WL, D_TB, D_YB, D_YTB, xacc, ti0, tj0, blk, l15, g);
        lds_barrier();
        neu_step<true, true, true>(L, D_TB, D_YB, D_YTB, D_XB, D_TBG, D_WL, xacc, ti0, tj0, blk, l15, g);
        lds_barrier();
        neu_step<true, true, false>(L, D_XB, D_TBG, D_WL, D_TB, 0, D_YTB, xacc, ti0, tj0, blk, l15, g);
        lds_barrier();
        neu_step<true, false, false>(L, D_TB, 0, D_YTB, D_XB, 0, 0, xacc, ti0, tj0, blk, l15, g);
        lds_barrier();
        {
            const int wo0 = (16 * tj0 + l15) * 144 + (16 * ti0 + 4 * g) * 2;
            const LAS float* be = BETA + 16 * ti0 + 4 * g; const LAS float* eg = EG + 16 * ti0 + 4 * g;
            const float t0 = xacc[0] * be[0], t1 = xacc[1] * be[1], t2 = xacc[2] * be[2], t3 = xacc[3] * be[3];
            st8(L, D_TB + wo0, pack4(t0, t1, t2, t3));
            st8(L, D_TBG + wo0, pack4(t0 * eg[0], t1 * eg[1], t2 * eg[2], t3 * eg[3]));
        }
        const int ct2 = 2 + ((wave >> 1) & 1), rt2 = wave & 1;
        if (wave < 4) {
            const bf16x8 aa = lds16(L, D_AB + (16 * ct2 + l15) * 144 + 16 * g);
            const int tq = D_XB + (8 * g + (l15 >> 2)) * 144 + (16 * rt2 + 4 * (l15 & 3)) * 2;
            const bf16x8 tb = cat8(lds_tr(L, tq), lds_tr(L, tq + 4 * 144));
            const f32x4 m = mfma32(aa, tb, (f32x4){0.f, 0.f, 0.f, 0.f});
            st8(L, D_MT + (16 * rt2 + l15) * 144 + (16 * (ct2 - 2) + 4 * g) * 2, pack4(m[0], m[1], m[2], m[3]));
        } else {
            const int zo = (16 * ((wave >> 1) & 1) + l15) * 144 + (16 * (2 + (wave & 1)) + 4 * g) * 2;
            st8(L, D_TB + zo, pack4(0.f, 0.f, 0.f, 0.f)); st8(L, D_TBG + zo, pack4(0.f, 0.f, 0.f, 0.f));
        }
        lds_barrier();
        if (wave < 4) {
            const f32x4 t = mfma32(lds16(L, D_MT + (16 * rt2 + l15) * 144 + 16 * g), lds16(L, D_XB + (16 * ct2 + l15) * 144 + 64 + 16 * g), (f32x4){0.f, 0.f, 0.f, 0.f});
            const LAS float* be = BETA + 16 * rt2 + 4 * g; const LAS float* eg = EG + 16 * rt2 + 4 * g;
            const float t0 = -t[0] * be[0], t1 = -t[1] * be[1], t2 = -t[2] * be[2], t3 = -t[3] * be[3];
            const int wo2 = (16 * ct2 + l15) * 144 + (16 * rt2 + 4 * g) * 2;
            st8(L, D_TB + wo2, pack4(t0, t1, t2, t3));
            st8(L, D_TBG + wo2, pack4(t0 * eg[0], t1 * eg[1], t2 * eg[2], t3 * eg[3]));
        }
        lds_barrier();
        }
        bf16_t* zrow = dz + (size_t)(t0 + (tid >> 3)) * 4096 + (tid & 7) * 16;
        const u32x4 zz0 = *(const u32x4*)zrow, zz1 = *(const u32x4*)(zrow + 8);
        f32x4 vn[4];
#pragma unroll
        for (int ct = 0; ct < 4; ++ct) {
            const int rt = (16 * ct + l15) * 144 + 16 * g;
            const int tq = (8 * g + (l15 >> 2)) * 272 + (16 * wave + 4 * (l15 & 3)) * 2;
            f32x4 u = (f32x4){0.f, 0.f, 0.f, 0.f}, wt = u;
#pragma unroll
            for (int ks = 0; ks < 2; ++ks) {
                const bf16x8 vb = cat8(lds_tr(L, D_VS + tq + ks * 32 * 272), lds_tr(L, D_VS + tq + ks * 32 * 272 + 4 * 272));
                const bf16x8 ka = cat8(lds_tr(L, D_KS + tq + ks * 32 * 272), lds_tr(L, D_KS + tq + ks * 32 * 272 + 4 * 272));
                u = mfma32(lds16(L, D_TB + rt + ks * 64), vb, u);
                wt = mfma32(ka, lds16(L, D_TBG + rt + ks * 64), wt);
            }
            vn[ct] = u;
            st8(L, D_WL + (16 * ct + l15) * 272 + (16 * wave + 4 * g) * 2, pack4(wt[0], wt[1], wt[2], wt[3]));
        }
        lds_barrier();
        f32x4 oq[4];
        {
            bf16x8 sb[4];
#pragma unroll
            for (int kb = 0; kb < 4; ++kb) sb[kb] = pack8(Sacc[2 * kb], Sacc[2 * kb + 1]);
#pragma unroll
            for (int ct = 0; ct < 4; ++ct) {
                f32x4 ws = (f32x4){0.f, 0.f, 0.f, 0.f}, qs = ws;
#pragma unroll
                for (int kb = 0; kb < 4; ++kb) {
                    ws = mfma32(lds_perm(L, D_WL + (16 * ct + l15) * 272 + (32 * kb + 4 * g) * 2), sb[kb], ws);
                    qs = mfma32(lds_perm(L, D_QS + (16 * ct + l15) * 272 + (32 * kb + 4 * g) * 2), sb[kb], qs);
                }
                vn[ct] = vn[ct] - ws;
#pragma unroll
                for (int j = 0; j < 4; ++j) qs[j] *= EG[16 * ct + 4 * g + j];
                oq[ct] = qs;
            }
        }
        {
            const bf16x8 vb0 = pack8(vn[0], vn[1]), vb1 = pack8(vn[2], vn[3]);
#pragma unroll
            for (int ct = 0; ct < 4; ++ct) {
                const int ro = D_QKM + (16 * ct + l15) * 144 + (4 * g) * 2;
                oq[ct] = mfma32(lds_perm(L, ro), vb0, oq[ct]);
                oq[ct] = mfma32(lds_perm(L, ro + 64), vb1, oq[ct]);
            }
            const float gl = GC[63], egl = __expf(gl);
            f32x4 vs[4];
#pragma unroll
            for (int ct = 0; ct < 4; ++ct)
#pragma unroll
                for (int j = 0; j < 4; ++j) vs[ct][j] = vn[ct][j] * __expf(gl - GC[16 * ct + 4 * g + j]);
            const bf16x8 sb0 = pack8(vs[0], vs[1]), sb1 = pack8(vs[2], vs[3]);
#pragma unroll
            for (int dk = 0; dk < 8; ++dk) {
                const int tk = D_KS + (4 * g + (l15 >> 2)) * 272 + (16 * dk + 4 * (l15 & 3)) * 2;
                f32x4 s = Sacc[dk] * egl;
                s = mfma32(cat8(lds_tr(L, tk), lds_tr(L, tk + 16 * 272)), sb0, s);
                s = mfma32(cat8(lds_tr(L, tk + 32 * 272), lds_tr(L, tk + 48 * 272)), sb1, s);
                Sacc[dk] = s;
            }
        }
#pragma unroll
        for (int ct = 0; ct < 4; ++ct)
#pragma unroll
            for (int j = 0; j < 4; ++j) {
                const float ss = sum16(oq[ct][j] * oq[ct][j]);
                if (l15 == 0) RED[(16 * ct + 4 * g + j) * 8 + wave] = ss;
            }
        lds_barrier();
#pragma unroll
        for (int ct = 0; ct < 4; ++ct)
#pragma unroll
            for (int j = 0; j < 4; ++j) {
                const int c = 16 * ct + 4 * g + j;
                const f32x4 r0 = *(const LAS f32x4*)(RED + c * 8), r1 = *(const LAS f32x4*)(RED + c * 8 + 4);
                const float tot = r0[0] + r0[1] + r0[2] + r0[3] + r1[0] + r1[1] + r1[2] + r1[3];
                const float rs = rsqrtf(tot * (1.f / 128.f) + 1e-6f);
                *(LAS unsigned short*)(L + D_XB + c * 272 + (16 * wave + l15) * 2) = (unsigned short)(pk_bf16(oq[ct][j] * rs * dnw, 0.f) & 0xffffu);
            }
        lds_barrier();
        {
            const u32x4 o0 = *(const LAS u32x4*)(L + D_XB + (tid >> 3) * 272 + (tid & 7) * 32), o1 = *(const LAS u32x4*)(L + D_XB + (tid >> 3) * 272 + (tid & 7) * 32 + 16);
            u32x4 w0, w1;
#pragma unroll
            for (int e = 0; e < 4; ++e) {
                w0[e] = pk_bf16(bflo(o0[e]) * siluf_(bflo(zz0[e])), bfhi(o0[e]) * siluf_(bfhi(zz0[e])));
                w1[e] = pk_bf16(bflo(o1[e]) * siluf_(bflo(zz1[e])), bfhi(o1[e]) * siluf_(bfhi(zz1[e])));
            }
            bf16_t* op = dry ? ((bf16_t*)(P.ws + WS_WIN_T) + ((size_t)(zrow - (bf16_t*)(P.ws + WS_DZ)) & 0x1fffff0u)) : zrow;
            *(u32x4*)op = w0; *(u32x4*)(op + 8) = w1;
        }
    }
    lds_barrier();
}


#define XB_TMO      128
#define XB_XCNT(j)  (256  + 64 * (j))
#define XB_XSUB(j)  (1280 + 64 * (j))
#define XB_XGEN(j)  (2304 + 64 * (j))
#define XB_TOP      3328
#define XB_TOPGEN   3392
#define XCD_BAR_WORDS 3456
#define XB_SPIN_CAP (1u << 18)
DI unsigned xb_ld(unsigned* p)              { return __hip_atomic_load(p, __ATOMIC_RELAXED, __HIP_MEMORY_SCOPE_AGENT); }
DI unsigned xb_add(unsigned* p, unsigned v) { return __hip_atomic_fetch_add(p, v, __ATOMIC_RELAXED, __HIP_MEMORY_SCOPE_AGENT); }
DI unsigned xb_xcc_id() { return (unsigned)__builtin_amdgcn_s_getreg((3 << 11) | 20) & 0xFu; }
#define XB_SPIN(cond, bar) do { unsigned _sp = 0; while (cond) { __builtin_amdgcn_s_sleep(1); \
    if ((++_sp & 255u) == 0u) { if (xb_ld(&(bar)[XB_TMO])) break; if (_sp > XB_SPIN_CAP) { atomicAdd(&(bar)[XB_TMO], 1u); break; } } } } while (0)
struct XcdBarrier { unsigned* bar; unsigned x; volatile LAS unsigned* st; };
DI XcdBarrier xcd_barrier_post(unsigned* bar, volatile LAS unsigned* st) {
    XcdBarrier b; b.bar = bar; b.x = xb_xcc_id(); b.st = st;
    if (threadIdx.x == 0) (void)xb_add(&bar[XB_XCNT(b.x)], 1u);
    return b;
}
DI void xcd_barrier_complete(unsigned* bar, unsigned x, unsigned& nloc, unsigned& nx) {
    const unsigned G = gridDim.x * gridDim.y * gridDim.z;
    unsigned sum, cnt, mine, sp = 0u;
    for (;;) {
        sum = 0u; cnt = 0u; mine = 0u;
#pragma unroll
        for (unsigned j = 0; j < 16; ++j) { const unsigned c = xb_ld(&bar[XB_XCNT(j)]); sum += c; cnt += (c > 0u) ? 1u : 0u; mine = (j == x) ? c : mine; }
        if (sum == G) break;
        __builtin_amdgcn_s_sleep(1);
        if ((++sp & 255u) == 0u) { if (xb_ld(&bar[XB_TMO])) break; if (sp > XB_SPIN_CAP) { atomicAdd(&bar[XB_TMO], 1u); break; } }
    }
    nloc = mine > 0u ? mine : 1u; nx = cnt > 0u ? cnt : 1u;
}
DI void xcd_barrier(const XcdBarrier& b) {
    asm volatile("s_waitcnt vmcnt(0)" ::: "memory");
    __syncthreads();
    if (threadIdx.x == 0) {
        unsigned* bar = b.bar;
        __builtin_amdgcn_s_waitcnt(0);
        unsigned nloc = b.st[0], nx = b.st[1];
        if (nloc == 0u) { xcd_barrier_complete(bar, b.x, nloc, nx); b.st[0] = nloc; b.st[1] = nx; }
        const unsigned old = xb_add(&bar[XB_XSUB(b.x)], 1u);
        const unsigned gen = old / nloc;
        if (old + 1u == (gen + 1u) * nloc) {
            __builtin_amdgcn_fence(__ATOMIC_RELEASE, "agent");
            asm volatile("s_waitcnt vmcnt(0)" ::: "memory");
            const unsigned og = xb_add(&bar[XB_TOP], 1u);
            const unsigned tg = og / nx;
            if (og + 1u == (tg + 1u) * nx) xb_add(&bar[XB_TOPGEN], 1u);
            else XB_SPIN(xb_ld(&bar[XB_TOPGEN]) == tg, bar);
            __builtin_amdgcn_fence(__ATOMIC_ACQUIRE, "agent");
            xb_add(&bar[XB_XGEN(b.x)], 1u);
            asm volatile("s_waitcnt vmcnt(0)" ::: "memory");
        } else {
            XB_SPIN(xb_ld(&bar[XB_XGEN(b.x)]) == gen, bar);
            __builtin_amdgcn_fence(__ATOMIC_ACQUIRE, "agent");
            asm volatile("s_waitcnt vmcnt(0)" ::: "memory");
        }
    }
    __syncthreads();
}

__global__ void __launch_bounds__(512, 2) fwd_megakernel(Params P) {
    extern __shared__ __attribute__((aligned(16))) unsigned char lds_raw[];
    LAS unsigned char* L = (LAS unsigned char*)lds_raw;
    cg::grid_group grid = cg::this_grid();
#define FRESH_IDS const int tid = fresh_tid(), lane = tid & 63, wave = __builtin_amdgcn_readfirstlane(tid >> 6)
    const int G = gridDim.x, c = blockIdx.x;
    unsigned* const bar = (unsigned*)(P.ws + WS_BAR);
    {
        if (threadIdx.x == 0) { *(volatile LAS unsigned*)(L + LDS_BYTES - 16) = 0u; *(volatile LAS unsigned*)(L + LDS_BYTES - 12) = 0u; }
        __syncthreads();
    }
    const XcdBarrier xb = xcd_barrier_post(bar, (volatile LAS unsigned*)(L + LDS_BYTES - 16));
    if (P.ws == nullptr) grid.sync();
    bf16_t* hoa = (bf16_t*)P.out;

#ifndef PH_MASK
#define PH_MASK 0xFF
#endif
    if (PH_MASK & 1) { FRESH_IDS; phase_prologue(P, L, tid, wave, lane); }
    xcd_barrier(xb);
    if (PH_MASK & 2) {
        Sched1 S{(const char*)hoa, (const char*)(P.ws + WS_WIN_T), G, c};
        Epi1 E{(bf16_t*)(P.ws + WS_QKVA), hoa, (bf16_t*)(P.ws + WS_DQKV), (bf16_t*)(P.ws + WS_DZ), (float*)(P.ws + WS_BETA), (float*)(P.ws + WS_G), P.b_qkv, P.a_log, P.dt_bias};
        pg8::gemm_phase<Epi1, Sched1>(L, 4096, 2048, S, E);
    }
    xcd_barrier(xb);
    if (PH_MASK & 4) { FRESH_IDS; for (int item = c; item < 1024; item += G) attn_item(P, L, item, tid, wave, lane); }
    if (PH_MASK & 8) { FRESH_IDS; for (int seq = c; seq < 256; seq += G) deltanet_seq(P, L, seq, tid, wave, lane); }
    xcd_barrier(xb);
    if (PH_MASK & 16) {
        Sched2 S{(const char*)hoa, (const char*)(P.ws + WS_DZ), (const char*)(P.ws + WS_W2A_T), (const char*)(P.ws + WS_W2B_T), (const char*)(P.ws + WS_WDN_T), G, c};
        Epi2 E{(bf16_t*)(P.ws + WS_QKVA), P.ws + WS_GSCR + (size_t)c * 131072};
        pg8::gemm_phase<Epi2, Sched2>(L, 4096, 4096, S, E);
    }
    xcd_barrier(xb);
    if (PH_MASK & 32) {
        Sched3 S{(const char*)(P.ws + WS_QKVA), (const char*)(P.ws + WS_WOUT_T), G, c};
        Epi3 E{P.x, P.out, (float*)(P.ws + WS_PART)};
        pg8::gemm_phase<Epi3, Sched3>(L, 2048, 2048, S, E);
    }
    xcd_barrier(xb);
    {
        FRESH_IDS;
        const float* part = (const float*)(P.ws + WS_PART);
        f32x4 fw[8];
#pragma unroll
        for (int i = 0; i < 8; ++i) fw[i] = *(const f32x4*)(P.final_w + (i * 64 + lane) * 4);
        for (int row = c * 8 + wave; row < MTOK; row += G * 16) {
            const int row2r = row + G * 8; const bool has2 = row2r < MTOK; const int row2 = has2 ? row2r : row;
            float ss = part[(size_t)row * 32 + (lane & 31)], ss2 = part[(size_t)row2 * 32 + (lane & 31)];
            float* o = P.out + (size_t)row * 2048; float* o2 = P.out + (size_t)row2 * 2048;
            f32x4 v[8], u[8];
#pragma unroll
            for (int i = 0; i < 8; ++i) { v[i] = *(const f32x4*)(o + (i * 64 + lane) * 4); u[i] = *(const f32x4*)(o2 + (i * 64 + lane) * 4); }
#pragma unroll
            for (int d = 1; d < 32; d <<= 1) { ss += __shfl_xor(ss, d); ss2 += __shfl_xor(ss2, d); }
            const float rs = rsqrtf(ss * (1.f / 2048.f) + 1e-6f), rs2 = rsqrtf(ss2 * (1.f / 2048.f) + 1e-6f);
#pragma unroll
            for (int i = 0; i < 8; ++i) {
                const f32x4 w = fw[i];
                f32x4 a = v[i]; a[0] *= rs * w[0]; a[1] *= rs * w[1]; a[2] *= rs * w[2]; a[3] *= rs * w[3];
                *(f32x4*)(o + (i * 64 + lane) * 4) = a;
                if (has2) { f32x4 q = u[i]; q[0] *= rs2 * w[0]; q[1] *= rs2 * w[1]; q[2] *= rs2 * w[2]; q[3] *= rs2 * w[3]; *(f32x4*)(o2 + (i * 64 + lane) * 4) = q; }
            }
        }
    }
}

extern "C" void kernel_launch(void* const* d_in, const int* in_sizes, int n_in, void* d_out, int out_size, void* d_ws, size_t ws_size, hipStream_t stream) {
    static int grid_blocks = 0;
    if (grid_blocks == 0) {
        if (ws_size < WS_END) { fprintf(stderr, "kernel_launch: workspace too small: %zu < %zu\n", ws_size, (size_t)WS_END); grid_blocks = -1; return; }
        int dev = 0, cus = 0, per_cu = 0;
        hipGetDevice(&dev);
        hipDeviceGetAttribute(&cus, hipDeviceAttributeMultiprocessorCount, dev);
        if (hipFuncSetAttribute((const void*)fwd_megakernel, hipFuncAttributeMaxDynamicSharedMemorySize, LDS_BYTES) != hipSuccess) { fprintf(stderr, "kernel_launch: hipFuncSetAttribute failed\n"); }
        if (hipOccupancyMaxActiveBlocksPerMultiprocessor(&per_cu, (const void*)fwd_megakernel, 512, LDS_BYTES) != hipSuccess || per_cu < 1) { fprintf(stderr, "kernel_launch: occupancy query gives %d\n", per_cu); per_cu = 1; }
        (void)hipGetLastError();
        grid_blocks = cus * per_cu;
        if (grid_blocks > 256) grid_blocks = 256;
    }
    if (grid_blocks < 0) return;
    Params p{};
    p.x = (const float*)d_in[0]; p.norm_w = (const float*)d_in[1]; p.w_in = (const float*)d_in[2]; p.b_qkv = (const float*)d_in[3];
    p.sinks = (const float*)d_in[4]; p.conv_w = (const float*)d_in[5]; p.a_log = (const float*)d_in[6]; p.dt_bias = (const float*)d_in[7];
    p.dn_norm_w = (const float*)d_in[8]; p.w_att = (const float*)d_in[9]; p.w_dn = (const float*)d_in[10]; p.w_out = (const float*)d_in[11];
    p.final_w = (const float*)d_in[12]; p.out = (float*)d_out; p.ws = (unsigned char*)d_ws;
    if (hipMemsetAsync((char*)d_ws + WS_BAR, 0, WS_BAR_BYTES, stream) != hipSuccess) { fprintf(stderr, "kernel_launch: memset of the barrier words failed\n"); return; }
    void* args[] = {&p};
    hipError_t e = hipLaunchCooperativeKernel((const void*)fwd_megakernel, dim3(grid_blocks), dim3(512), args, LDS_BYTES, stream);
    if (e != hipSuccess) fprintf(stderr, "cooperative launch failed: %s (grid %d)\n", hipGetErrorString(e), grid_blocks);
}
```

```cpp
#include <hip/hip_runtime.h>
#include <hip/hip_cooperative_groups.h>
#include <cstdio>
namespace cg = cooperative_groups;

#define LAS __attribute__((address_space(3)))
#define DI __device__ __forceinline__
typedef unsigned short bf16_t;
typedef short bf16x8 __attribute__((ext_vector_type(8)));
typedef short bf16x4 __attribute__((ext_vector_type(4)));
typedef float f32x4 __attribute__((ext_vector_type(4)));
typedef unsigned u32x4 __attribute__((ext_vector_type(4)));
typedef unsigned u32x2 __attribute__((ext_vector_type(2)));

constexpr int MTOK = 16384, DM = 2048, SEQ = 2048;
constexpr int N1 = 17152;
constexpr size_t MB = 1u << 20;
constexpr size_t WS_WIN_T = 0;
constexpr size_t WS_W2A_T = WS_WIN_T + (size_t)N1 * 2048 * 2;
constexpr size_t WS_W2B_T = WS_W2A_T + (size_t)2048 * 4096 * 2;
constexpr size_t WS_WDN_T = WS_W2B_T + (size_t)2048 * 4096 * 2;
constexpr size_t WS_WOUT_T = WS_WDN_T + (size_t)2048 * 4096 * 2;
constexpr size_t WS_QKVA = WS_WOUT_T + (size_t)2048 * 2048 * 2;
constexpr size_t WS_DQKV = WS_QKVA + (size_t)MTOK * 2560 * 2;
constexpr size_t WS_DZ = WS_DQKV + (size_t)MTOK * 8192 * 2;
constexpr size_t WS_BETA = WS_DZ + (size_t)MTOK * 4096 * 2;
constexpr size_t WS_G = WS_BETA + (size_t)MTOK * 32 * 4;
constexpr size_t WS_BAR = WS_G + (size_t)MTOK * 32 * 4;
constexpr size_t WS_BAR_BYTES = 16384;
constexpr size_t WS_END = WS_BAR + WS_BAR_BYTES;
constexpr size_t WS_GSCR = WS_DQKV;
constexpr size_t WS_PART = WS_DQKV + 64 * MB;

constexpr int LDS_BYTES = 155648;

struct Params {
    const float* x; const float* norm_w; const float* w_in; const float* b_qkv; const float* sinks; const float* conv_w;
    const float* a_log; const float* dt_bias; const float* dn_norm_w; const float* w_att; const float* w_dn; const float* w_out;
    const float* final_w; float* out; unsigned char* ws;
};

typedef __bf16 bf2_t __attribute__((ext_vector_type(2)));
typedef float f32x2 __attribute__((ext_vector_type(2)));
DI unsigned pk_bf16(float lo, float hi) { f32x2 v = {lo, hi}; bf2_t b = __builtin_convertvector(v, bf2_t); return __builtin_bit_cast(unsigned, b); }
DI int fresh_tid() { int t = threadIdx.x; asm volatile("" : "+v"(t)); return t; }
DI float bf2f(unsigned short b) { return __uint_as_float(((unsigned)b) << 16); }
DI float bflo(unsigned u) { return __uint_as_float(u << 16); }
DI float bfhi(unsigned u) { return __uint_as_float(u & 0xffff0000u); }
DI float sigmoidf_(float x) { return __builtin_amdgcn_rcpf(1.f + __expf(-x)); }
DI float siluf_(float x) { return x * sigmoidf_(x); }
DI f32x4 mfma32(bf16x8 a, bf16x8 b, f32x4 c) { return __builtin_amdgcn_mfma_f32_16x16x32_bf16(a, b, c, 0, 0, 0); }
DI f32x4 mfma16(bf16x4 a, bf16x4 b, f32x4 c) { return __builtin_amdgcn_mfma_f32_16x16x16bf16_1k(a, b, c, 0, 0, 0); }
DI bf16x4 pack4(float a, float b, float c, float d) { u32x2 w; w.x = pk_bf16(a, b); w.y = pk_bf16(c, d); return __builtin_bit_cast(bf16x4, w); }
DI bf16x8 pack8(f32x4 a, f32x4 b) { u32x4 w; w.x = pk_bf16(a[0], a[1]); w.y = pk_bf16(a[2], a[3]); w.z = pk_bf16(b[0], b[1]); w.w = pk_bf16(b[2], b[3]); return __builtin_bit_cast(bf16x8, w); }
DI bf16x8 lds16(LAS unsigned char* L, int off) { return *(const LAS bf16x8*)(L + off); }
DI bf16x4 lds8(LAS unsigned char* L, int off) { return *(const LAS bf16x4*)(L + off); }
DI bf16x8 lds_perm(LAS unsigned char* L, int off) {
    bf16x4 lo = *(const LAS bf16x4*)(L + off), hi = *(const LAS bf16x4*)(L + off + 32);
    return __builtin_shufflevector(lo, hi, 0, 1, 2, 3, 4, 5, 6, 7);
}
DI bf16x4 lds_tr(LAS unsigned char* L, int off) { return __builtin_amdgcn_ds_read_tr16_b64_v4i16((LAS bf16x4*)(L + off)); }
DI bf16x8 cat8(bf16x4 lo, bf16x4 hi) { return __builtin_shufflevector(lo, hi, 0, 1, 2, 3, 4, 5, 6, 7); }
DI float sum16(float v) {
    v += __builtin_bit_cast(float, __builtin_amdgcn_mov_dpp(__builtin_bit_cast(int, v), 0xB1, 0xf, 0xf, true));
    v += __builtin_bit_cast(float, __builtin_amdgcn_mov_dpp(__builtin_bit_cast(int, v), 0x4E, 0xf, 0xf, true));
    v += __builtin_bit_cast(float, __builtin_amdgcn_mov_dpp(__builtin_bit_cast(int, v), 0x141, 0xf, 0xf, true));
    v += __builtin_bit_cast(float, __builtin_amdgcn_mov_dpp(__builtin_bit_cast(int, v), 0x140, 0xf, 0xf, true));
    return v;
}
DI void lds_barrier() { asm volatile("s_waitcnt lgkmcnt(0)\n\ts_barrier" ::: "memory"); }
DI void st8(LAS unsigned char* L, int off, bf16x4 v) { *(LAS bf16x4*)(L + off) = v; }

namespace pg8 {
constexpr int BM = 256, BK = 64, HALF = 128, HTB = HALF * BK * 2, STAGE_BYTES = 8 * HTB, NXCD = 8, WGM = 8;
DI int lds_byte(int r, int c) { const int st = (r >> 4) * 2 + (c >> 5), rr = r & 15, cc = c & 31, ob = rr * 64 + cc * 2; return st * 1024 + (ob ^ (((ob >> 9) & 1) << 5)); }
DI void stage_rc(int b, int& R, int& C) { const int st = b / 1024, sb = b % 1024, swz = sb ^ (((sb >> 9) & 1) << 5); R = (st >> 1) * 16 + swz / 64; C = (st & 1) * 32 + (swz % 64) / 2; }
DI int perm32(int rho) { const int n = rho >> 4, i = rho & 15; return 8 * (i >> 2) + 4 * n + (i & 3); }

struct Unit { int pm, pn, tag, nt; const char* A; const char* B; };

DI void map_tile(int L, int nM, int nN, int& pm, int& pn) {
    const int nwg = nM * nN; int wgid = L;
    { const int q = nwg / NXCD, r = nwg % NXCD, xcd = wgid % NXCD, off = wgid / NXCD; wgid = (xcd < r ? xcd * (q + 1) : r * (q + 1) + (xcd - r) * q) + off; }
    const int nig = WGM * nN, gid = wgid / nig, fm = gid * WGM, gsz = (nM - fm) < WGM ? (nM - fm) : WGM;
    pm = fm + ((wgid % nig) % gsz); pn = (wgid % nig) / gsz;
}

template <class Epi, class Sched>
DI void gemm_phase(LAS unsigned char* lds, const int lda, const int ldb, const Sched& S, const Epi& E) {
    const int tid = fresh_tid(), wid = __builtin_amdgcn_readfirstlane(tid >> 6), lane = tid & 63, wr = wid >> 2, wc = wid & 3, fr = lane & 15, fq = lane >> 4;
    unsigned voffA[2], voffB[2];
#pragma unroll
    for (int i = 0; i < 2; ++i) { int R, C; stage_rc(tid * 16 + i * 8192, R, C); const int Rb = Epi::PERM ? ((R & ~31) + perm32(R & 31)) : R;
        voffA[i] = (unsigned)(R * lda + C) * 2u; voffB[i] = (unsigned)(Rb * ldb + C) * 2u; }
    const size_t kstep = (size_t)(BK * 2);
    const size_t hstepA = (size_t)HALF * lda * 2, hstepB = (size_t)HALF * ldb * 2;
    const unsigned ldsw = (unsigned)wid * 1024u;
    const int aoff = lds_byte(wr * 64 + fr, fq * 8), boff = lds_byte(wc * 32 + fr, fq * 8);
#define PG8_SA(b, h) (((b) * 2 + (h)) * HTB)
#define PG8_SB(b, h) ((4 + (b) * 2 + (h)) * HTB)
#define PG8_STAGE(bufoff, gbase, voff) do { _Pragma("unroll") for (int _i = 0; _i < 2; ++_i) \
        __builtin_amdgcn_global_load_lds((const unsigned*)((const char*)(gbase) + (voff)[_i]), (LAS unsigned*)(lds + (bufoff) + ldsw + _i * 8192), 16, 0, 0); } while (0)
#define PG8_LDA(dst, b, h) do { _Pragma("unroll") for (int m = 0; m < 4; ++m) _Pragma("unroll") for (int k = 0; k < 2; ++k) dst[m][k] = *(const LAS bf16x8*)(lds + PG8_SA(b, h) + aoff + m * 2048 + k * 1024); } while (0)
#define PG8_LDB(dst, b, h) do { _Pragma("unroll") for (int n = 0; n < 2; ++n) _Pragma("unroll") for (int k = 0; k < 2; ++k) dst[n][k] = *(const LAS bf16x8*)(lds + PG8_SB(b, h) + boff + n * 2048 + k * 1024); } while (0)
#define PG8_MMA(ai, bj, At, Bt) do { __builtin_amdgcn_s_setprio(1); _Pragma("unroll") for (int m = 0; m < 4; ++m) _Pragma("unroll") for (int n = 0; n < 2; ++n) _Pragma("unroll") for (int k = 0; k < 2; ++k) \
        acc[ai][bj][m][n] = __builtin_amdgcn_mfma_f32_16x16x32_bf16(Bt[n][k], At[m][k], acc[ai][bj][m][n], 0, 0, 0); __builtin_amdgcn_s_setprio(0); } while (0)
#define PG8_WAIT_V(n) asm volatile("s_waitcnt vmcnt(" #n ")" ::: "memory")
#define PG8_WAIT_L(n) asm volatile("s_waitcnt lgkmcnt(" #n ")" ::: "memory")
#define PG8_BAR __builtin_amdgcn_s_barrier()
#define PG8_SCHED __builtin_amdgcn_sched_barrier(0)
    Unit cur, nxt; int ui = 0;
    if (!S.next(0, cur)) return;
    f32x4 acc[2][2][4][2];
#pragma unroll
    for (int a = 0; a < 2; ++a)
#pragma unroll
        for (int b = 0; b < 2; ++b)
#pragma unroll
            for (int m = 0; m < 4; ++m)
#pragma unroll
                for (int n = 0; n < 2; ++n) acc[a][b][m][n] = (f32x4){0.f, 0.f, 0.f, 0.f};
    bf16x8 At[4][2], B0[2][2], B1[2][2];
    const char* cA = cur.A; const char* cB = cur.B;
    PG8_STAGE(PG8_SB(0, 0), cB, voffB); PG8_STAGE(PG8_SA(0, 0), cA, voffA); PG8_STAGE(PG8_SB(0, 1), cB + hstepB, voffB); PG8_STAGE(PG8_SA(0, 1), cA + hstepA, voffA);
    if (wr == 1) PG8_BAR;
    PG8_WAIT_V(4); PG8_BAR;
    PG8_STAGE(PG8_SB(1, 0), cB + kstep, voffB); PG8_STAGE(PG8_SA(1, 0), cA + kstep, voffA); PG8_STAGE(PG8_SB(1, 1), cB + hstepB + kstep, voffB);
    PG8_WAIT_V(6); PG8_BAR;
    for (;;) {
        const bool has_next = S.next(ui + 1, nxt);
        const char* nA = has_next ? nxt.A : cA; const char* nB = has_next ? nxt.B : cB;
        const int nt = cur.nt;
        for (int t = 0; t < nt; t += 2) {
            const bool last = (t == nt - 2);
            const char* a1 = cA + (size_t)(t + 1) * kstep;
            const char* a2 = last ? nA : cA + (size_t)(t + 2) * kstep; const char* b2 = last ? nB : cB + (size_t)(t + 2) * kstep;
            const char* a3 = a2 + kstep; const char* b3 = b2 + kstep;
            PG8_LDB(B0, 0, 0); PG8_SCHED; PG8_LDA(At, 0, 0); PG8_STAGE(PG8_SA(1, 1), a1 + hstepA, voffA);
            PG8_WAIT_L(8); PG8_BAR; PG8_WAIT_L(0); PG8_MMA(0, 0, At, B0); PG8_BAR; PG8_SCHED;
            PG8_LDB(B1, 0, 1); PG8_STAGE(PG8_SB(0, 0), b2, voffB);
            PG8_BAR; PG8_WAIT_L(0); PG8_MMA(0, 1, At, B1); PG8_BAR;
            PG8_LDA(At, 0, 1); PG8_STAGE(PG8_SA(0, 0), a2, voffA);
            PG8_BAR; PG8_WAIT_L(0); PG8_MMA(1, 0, At, B0); PG8_BAR; PG8_SCHED;
            PG8_STAGE(PG8_SB(0, 1), b2 + hstepB, voffB);
            PG8_WAIT_V(6); PG8_BAR; PG8_MMA(1, 1, At, B1); PG8_BAR;
            PG8_LDB(B0, 1, 0); PG8_SCHED; PG8_LDA(At, 1, 0); PG8_STAGE(PG8_SA(0, 1), a2 + hstepA, voffA);
            PG8_WAIT_L(8); PG8_BAR; PG8_WAIT_L(0); PG8_MMA(0, 0, At, B0); PG8_BAR; PG8_SCHED;
            PG8_LDB(B1, 1, 1); PG8_STAGE(PG8_SB(1, 0), b3, voffB);
            PG8_BAR; PG8_WAIT_L(0); PG8_MMA(0, 1, At, B1); PG8_BAR;
            PG8_LDA(At, 1, 1); PG8_STAGE(PG8_SA(1, 0), a3, voffA);
            PG8_BAR; PG8_WAIT_L(0); PG8_MMA(1, 0, At, B0); PG8_BAR; PG8_SCHED;
            PG8_STAGE(PG8_SB(1, 1), b3 + hstepB, voffB);
            PG8_WAIT_V(6); PG8_BAR; PG8_MMA(1, 1, At, B1); PG8_BAR;
        }
        E(acc, cur, wr, wc, fr, fq);
        if (!has_next) break;
#pragma unroll
        for (int a = 0; a < 2; ++a)
#pragma unroll
            for (int b = 0; b < 2; ++b)
#pragma unroll
                for (int m = 0; m < 4; ++m)
#pragma unroll
                    for (int n = 0; n < 2; ++n) acc[a][b][m][n] = (f32x4){0.f, 0.f, 0.f, 0.f};
        cur = nxt; cA = nA; cB = nB; ++ui;
    }
    PG8_WAIT_V(0);
    if (wr == 0) PG8_BAR;
    PG8_BAR;
#undef PG8_SA
#undef PG8_SB
#undef PG8_STAGE
#undef PG8_LDA
#undef PG8_LDB
#undef PG8_MMA
#undef PG8_WAIT_V
#undef PG8_WAIT_L
#undef PG8_BAR
#undef PG8_SCHED
}
}

struct Sched1 {
    const char* A; const char* B; int G, c;
    DI bool next(int i, pg8::Unit& u) const {
        const int L = i * G + c; if (L >= 64 * 67) return false;
        pg8::map_tile(L, 64, 67, u.pm, u.pn); u.tag = 0; u.nt = 32;
        u.A = A + (size_t)u.pm * 256 * 4096 * 2; u.B = B + (size_t)u.pn * 256 * 2048 * 2; return true;
    }
};
struct Epi1 {
    static constexpr bool PERM = true;
    bf16_t* qkva; bf16_t* hoa; bf16_t* dqkv; bf16_t* dz; float* beta; float* g; const float* b_qkv; const float* a_log; const float* dt_bias;
    DI void operator()(const f32x4 (&acc)[2][2][4][2], const pg8::Unit& u, int wr, int wc, int fr, int fq) const {
        const int pn = u.pn;
        const int row0 = u.pm * 256 + wr * 64 + fr;
        const int cl0 = wc * 32 + 8 * fq;
        if (pn == 66) {
            if (wc < 2) {
                const int hc = 8 * fq;
#pragma unroll
                for (int ai = 0; ai < 2; ++ai)
#pragma unroll
                    for (int m = 0; m < 4; ++m) {
                        const int row = row0 + ai * 128 + m * 16;
                        f32x4 v0 = acc[ai][0][m][0], v1 = acc[ai][0][m][1], o0, o1;
                        if (wc == 0) {
#pragma unroll
                            for (int j = 0; j < 4; ++j) { o0[j] = sigmoidf_(v0[j]); o1[j] = sigmoidf_(v1[j]); }
                            *(f32x4*)(beta + (size_t)row * 32 + hc) = o0; *(f32x4*)(beta + (size_t)row * 32 + hc + 4) = o1;
                        } else {
#pragma unroll
                            for (int j = 0; j < 4; ++j) {
                                float p0 = v0[j] + dt_bias[hc + j], p1 = v1[j] + dt_bias[hc + 4 + j];
                                float s0 = fmaxf(p0, 0.f) + log1pf(__expf(-fabsf(p0))), s1 = fmaxf(p1, 0.f) + log1pf(__expf(-fabsf(p1)));
                                o0[j] = -__expf(a_log[hc + j]) * s0; o1[j] = -__expf(a_log[hc + 4 + j]) * s1;
                            }
                            *(f32x4*)(g + (size_t)row * 32 + hc) = o0; *(f32x4*)(g + (size_t)row * 32 + hc + 4) = o1;
                        }
                    }
            }
            return;
        }
        bf16_t* base; int ld, colt, mode;
        if (pn < 10) { base = qkva; ld = 2560; colt = pn * 256; mode = 0; }
        else if (pn < 18) { base = hoa + 2048; ld = 4096; colt = (pn - 10) * 256; mode = 1; }
        else if (pn < 50) { base = dqkv; ld = 8192; colt = (pn - 18) * 256; mode = 2; }
        else { base = dz; ld = 4096; colt = (pn - 50) * 256; mode = 1; }
#pragma unroll
        for (int bj = 0; bj < 2; ++bj) {
            const int col = colt + bj * 128 + cl0;
            f32x4 b0 = (f32x4){0.f, 0.f, 0.f, 0.f}, b1 = b0;
            if (mode == 0) { b0 = *(const f32x4*)(b_qkv + col); b1 = *(const f32x4*)(b_qkv + col + 4); }
#pragma unroll
            for (int ai = 0; ai < 2; ++ai)
#pragma unroll
                for (int m = 0; m < 4; ++m) {
                    const int row = row0 + ai * 128 + m * 16;
                    f32x4 v0 = acc[ai][bj][m][0] + b0, v1 = acc[ai][bj][m][1] + b1;
                    u32x4 w; w.x = pk_bf16(v0[0], v0[1]); w.y = pk_bf16(v0[2], v0[3]); w.z = pk_bf16(v1[0], v1[1]); w.w = pk_bf16(v1[2], v1[3]);
                    *(u32x4*)(base + (size_t)row * ld + col) = w;
                }
        }
    }
};

struct Sched2 {
    const char* hoa; const char* od; const char* w2a; const char* w2b; const char* wdn; int G, c;
    DI bool next(int i, pg8::Unit& u) const {
        const int L = (i >> 2) * G + c; if (L >= 64 * 8) return false;
        pg8::map_tile(L, 64, 8, u.pm, u.pn); const int sub = i & 3; u.tag = sub;
        const size_t ao = (size_t)u.pm * 256 * 4096 * 2, bo = (size_t)u.pn * 256 * 4096 * 2;
        if (sub == 0) { u.A = hoa + ao; u.B = w2b + bo; u.nt = 32; }
        else if (sub == 1) { u.A = od + ao; u.B = wdn + bo; u.nt = 64; }
        else if (sub == 2) { u.A = hoa + ao; u.B = w2a + bo; u.nt = 32; }
        else { u.A = hoa + ao + 4096; u.B = w2a + bo + 4096; u.nt = 32; }
        return true;
    }
};
struct Epi2 {
    static constexpr bool PERM = true;
    bf16_t* merged; unsigned char* scr;
    DI void operator()(const f32x4 (&acc)[2][2][4][2], const pg8::Unit& u, int wr, int wc, int fr, int fq) const {
        const int tag = u.tag;
        const int row0 = u.pm * 256 + wr * 64 + fr, col0 = u.pn * 256 + wc * 32 + 8 * fq;
        unsigned char* __restrict__ const sbase = scr + (size_t)threadIdx.x * 16;
        bf16_t* __restrict__ const mbase = merged + (size_t)row0 * 2048 + col0;
        if ((tag & 1) == 0) {
#pragma unroll
            for (int ai = 0; ai < 2; ++ai)
#pragma unroll
                for (int m = 0; m < 4; ++m)
#pragma unroll
                    for (int bj = 0; bj < 2; ++bj) {
                        f32x4 v0 = acc[ai][bj][m][0], v1 = acc[ai][bj][m][1];
#pragma unroll
                        for (int j = 0; j < 4; ++j) { v0[j] = sigmoidf_(v0[j]); v1[j] = sigmoidf_(v1[j]); }
                        u32x4 w; w.x = pk_bf16(v0[0], v0[1]); w.y = pk_bf16(v0[2], v0[3]); w.z = pk_bf16(v1[0], v1[1]); w.w = pk_bf16(v1[2], v1[3]);
                        *(u32x4*)(sbase + (size_t)((ai * 4 + m) * 2 + bj) * 8192) = w;
                    }
            return;
        }
        asm volatile("s_waitcnt vmcnt(0)" ::: "memory");
#pragma unroll
        for (int aq = 0; aq < 4; ++aq) {
            const int ai = aq >> 1, m0 = (aq & 1) * 2;
            u32x4 gt[4][2], pv[4][2];
#pragma unroll
            for (int m = m0; m < m0 + 2; ++m)
#pragma unroll
                for (int bj = 0; bj < 2; ++bj) {
                    gt[m][bj] = *(const u32x4*)(sbase + (size_t)((ai * 4 + m) * 2 + bj) * 8192);
                    pv[m][bj] = (tag == 3) ? *(const u32x4*)(mbase + (size_t)(ai * 128 + m * 16) * 2048 + bj * 128) : (u32x4){0u, 0u, 0u, 0u};
                }
#pragma unroll
            for (int m = m0; m < m0 + 2; ++m)
#pragma unroll
                for (int bj = 0; bj < 2; ++bj) {
                    const f32x4 v0 = acc[ai][bj][m][0], v1 = acc[ai][bj][m][1];
                    const u32x4 g4 = gt[m][bj], p4 = pv[m][bj];
                    float o[8];
                    o[0] = bflo(g4.x) * v0[0] + bflo(p4.x); o[1] = bfhi(g4.x) * v0[1] + bfhi(p4.x); o[2] = bflo(g4.y) * v0[2] + bflo(p4.y); o[3] = bfhi(g4.y) * v0[3] + bfhi(p4.y);
                    o[4] = bflo(g4.z) * v1[0] + bflo(p4.z); o[5] = bfhi(g4.z) * v1[1] + bfhi(p4.z); o[6] = bflo(g4.w) * v1[2] + bflo(p4.w); o[7] = bfhi(g4.w) * v1[3] + bfhi(p4.w);
                    u32x4 w; w.x = pk_bf16(o[0], o[1]); w.y = pk_bf16(o[2], o[3]); w.z = pk_bf16(o[4], o[5]); w.w = pk_bf16(o[6], o[7]);
                    *(u32x4*)(mbase + (size_t)(ai * 128 + m * 16) * 2048 + bj * 128) = w;
                }
        }
    }
};

struct Sched3 {
    const char* A; const char* B; int G, c;
    DI bool next(int i, pg8::Unit& u) const {
        const int L = i * G + c; if (L >= 64 * 8) return false;
        pg8::map_tile(L, 64, 8, u.pm, u.pn); u.tag = 0; u.nt = 32;
        u.A = A + (size_t)u.pm * 256 * 2048 * 2; u.B = B + (size_t)u.pn * 256 * 2048 * 2; return true;
    }
};
struct Epi3 {
    static constexpr bool PERM = false;
    const float* x; float* out; float* part;
    DI void operator()(const f32x4 (&acc)[2][2][4][2], const pg8::Unit& u, int wr, int wc, int fr, int fq) const {
        const int row0 = u.pm * 256 + wr * 64 + fr, col0 = u.pn * 256 + wc * 32 + 4 * fq;
        const float* __restrict__ const xb = x + (size_t)row0 * 2048 + col0;
        float* __restrict__ const ob = out + (size_t)row0 * 2048 + col0;
#pragma unroll
        for (int aq = 0; aq < 4; ++aq) {
            const int ai = aq >> 1, m0 = (aq & 1) * 2;
            f32x4 xs[4][2][2];
#pragma unroll
            for (int m = m0; m < m0 + 2; ++m)
#pragma unroll
                for (int bj = 0; bj < 2; ++bj)
#pragma unroll
                    for (int n = 0; n < 2; ++n) xs[m][bj][n] = *(const f32x4*)(xb + (size_t)(ai * 128 + m * 16) * 2048 + bj * 128 + n * 16);
#pragma unroll
            for (int m = m0; m < m0 + 2; ++m) {
                const int row = row0 + ai * 128 + m * 16;
                float ss = 0.f;
#pragma unroll
                for (int bj = 0; bj < 2; ++bj)
#pragma unroll
                    for (int n = 0; n < 2; ++n) {
                        const f32x4 v = acc[ai][bj][m][n] + xs[m][bj][n];
                        *(f32x4*)(ob + (size_t)(ai * 128 + m * 16) * 2048 + bj * 128 + n * 16) = v;
                        ss += v[0] * v[0] + v[1] * v[1] + v[2] * v[2] + v[3] * v[3];
                    }
                ss += __shfl_xor(ss, 16); ss += __shfl_xor(ss, 32);
                if (fq == 0) part[(size_t)row * 32 + u.pn * 4 + wc] = ss;
            }
        }
    }
};

struct TDesc { const float* src; bf16_t* dst; int lds, ldd; };
DI TDesc tile_desc(const Params& P, int t) {
    bf16_t* win_t = (bf16_t*)(P.ws + WS_WIN_T); bf16_t* w2a = (bf16_t*)(P.ws + WS_W2A_T); bf16_t* w2b = (bf16_t*)(P.ws + WS_W2B_T);
    bf16_t* wdn = (bf16_t*)(P.ws + WS_WDN_T); bf16_t* wout = (bf16_t*)(P.ws + WS_WOUT_T);
    constexpr int T_IN = 329 * 32, T_ATT = 1024, T_DN = 2048;
    TDesc d;
    if (t < T_IN) {
        const int nt = t >> 5, kt = t & 31; const int col = nt * 64;
        d.src = P.w_in + (size_t)(kt * 64) * 21056 + col; d.lds = 21056;
        if (col < 16960) { d.dst = win_t + (size_t)col * 2048 + kt * 64; d.ldd = 2048; }
        else if (col < 16960 + 2048) { d.dst = w2a + (size_t)(col - 16960) * 4096 + kt * 64; d.ldd = 4096; }
        else { d.dst = w2b + (size_t)(col - 16960 - 2048) * 4096 + kt * 64; d.ldd = 4096; }
    } else if (t < T_IN + T_ATT) {
        const int q = t - T_IN; const int nt = q >> 5, kt = q & 31;
        d.src = P.w_att + (size_t)(kt * 64) * 2048 + nt * 64; d.lds = 2048; d.dst = w2a + (size_t)(nt * 64) * 4096 + 2048 + kt * 64; d.ldd = 4096;
    } else if (t < T_IN + T_ATT + T_DN) {
        const int q = t - T_IN - T_ATT; const int nt = q >> 6, kt = q & 63;
        d.src = P.w_dn + (size_t)(kt * 64) * 2048 + nt * 64; d.lds = 2048; d.dst = wdn + (size_t)(nt * 64) * 4096 + kt * 64; d.ldd = 4096;
    } else {
        const int q = t - T_IN - T_ATT - T_DN; const int nt = q >> 5, kt = q & 31;
        d.src = P.w_out + (size_t)(kt * 64) * 2048 + nt * 64; d.lds = 2048; d.dst = wout + (size_t)(nt * 64) * 2048 + kt * 64; d.ldd = 2048;
    }
    return d;
}

DI void phase_prologue(const Params& P, LAS unsigned char* L, int tid, int wave, int lane) {
    LAS float* tile = (LAS float*)L;
    bf16_t* win_t = (bf16_t*)(P.ws + WS_WIN_T);
    constexpr int T_ALL = 329 * 32 + 1024 + 2048 + 1024;
    {
        const int r0 = tid >> 4, c4 = (tid & 15) * 4, n = tid >> 3, kc = (tid & 7) * 8;
        int t = blockIdx.x;
        f32x4 v0 = (f32x4){0.f, 0.f, 0.f, 0.f}, v1 = v0;
        TDesc d{};
        if (t < T_ALL) { d = tile_desc(P, t); v0 = *(const f32x4*)(d.src + (size_t)r0 * d.lds + c4); v1 = *(const f32x4*)(d.src + (size_t)(r0 + 32) * d.lds + c4); }
        while (t < T_ALL) {
            tile[r0 * 65 + c4 + 0] = v0[0]; tile[r0 * 65 + c4 + 1] = v0[1]; tile[r0 * 65 + c4 + 2] = v0[2]; tile[r0 * 65 + c4 + 3] = v0[3];
            tile[(r0 + 32) * 65 + c4 + 0] = v1[0]; tile[(r0 + 32) * 65 + c4 + 1] = v1[1]; tile[(r0 + 32) * 65 + c4 + 2] = v1[2]; tile[(r0 + 32) * 65 + c4 + 3] = v1[3];
            lds_barrier();
            const TDesc cur = d;
            t += gridDim.x;
            if (t < T_ALL) { d = tile_desc(P, t); v0 = *(const f32x4*)(d.src + (size_t)r0 * d.lds + c4); v1 = *(const f32x4*)(d.src + (size_t)(r0 + 32) * d.lds + c4); }
            float f[8];
#pragma unroll
            for (int e = 0; e < 8; ++e) f[e] = tile[(kc + e) * 65 + n];
            u32x4 w; w.x = pk_bf16(f[0], f[1]); w.y = pk_bf16(f[2], f[3]); w.z = pk_bf16(f[4], f[5]); w.w = pk_bf16(f[6], f[7]);
            *(u32x4*)(cur.dst + (size_t)n * cur.ldd + kc) = w;
            lds_barrier();
        }
    }
    {
        u32x4* z = (u32x4*)(win_t + (size_t)16960 * 2048);
        for (int i = blockIdx.x * 512 + tid; i < 192 * 2048 / 8; i += gridDim.x * 512) z[i] = (u32x4){0u, 0u, 0u, 0u};
    }
    bf16_t* hoa = (bf16_t*)P.out;
    f32x4 nw[8];
#pragma unroll
    for (int i = 0; i < 8; ++i) nw[i] = *(const f32x4*)(P.norm_w + (i * 64 + lane) * 4);
    for (int row = blockIdx.x * 8 + wave; row < MTOK; row += gridDim.x * 16) {
        const int row2 = row + gridDim.x * 8; const bool has2 = row2 < MTOK;
        const float* xr = P.x + (size_t)row * 2048; const float* xr2 = P.x + (size_t)(has2 ? row2 : row) * 2048;
        f32x4 v[8], u[8]; float ss = 0.f, ss2 = 0.f;
#pragma unroll
        for (int i = 0; i < 8; ++i) { v[i] = *(const f32x4*)(xr + (i * 64 + lane) * 4); u[i] = *(const f32x4*)(xr2 + (i * 64 + lane) * 4); }
#pragma unroll
        for (int i = 0; i < 8; ++i) {
            ss += v[i][0] * v[i][0] + v[i][1] * v[i][1] + v[i][2] * v[i][2] + v[i][3] * v[i][3];
            ss2 += u[i][0] * u[i][0] + u[i][1] * u[i][1] + u[i][2] * u[i][2] + u[i][3] * u[i][3];
        }
#pragma unroll
        for (int d = 1; d < 64; d <<= 1) { ss += __shfl_xor(ss, d); ss2 += __shfl_xor(ss2, d); }
        const float rs = rsqrtf(ss * (1.f / 2048.f) + 1e-6f), rs2 = rsqrtf(ss2 * (1.f / 2048.f) + 1e-6f);
#pragma unroll
        for (int i = 0; i < 8; ++i) {
            const f32x4 w = nw[i];
            u32x2 o; o.x = pk_bf16(v[i][0] * rs * w[0], v[i][1] * rs * w[1]); o.y = pk_bf16(v[i][2] * rs * w[2], v[i][3] * rs * w[3]);
            *(u32x2*)(hoa + (size_t)row * 4096 + (i * 64 + lane) * 4) = o;
            if (has2) {
                u32x2 o2; o2.x = pk_bf16(u[i][0] * rs2 * w[0], u[i][1] * rs2 * w[1]); o2.y = pk_bf16(u[i][2] * rs2 * w[2], u[i][3] * rs2 * w[3]);
                *(u32x2*)(hoa + (size_t)row2 * 4096 + (i * 64 + lane) * 4) = o2;
            }
        }
    }
}

constexpr int A_KA = 0, A_VT = 27648;
DI void attn_item(const Params& P, LAS unsigned char* L, int item, int tid, int wave, int lane, int dry = 0) {
    const int tb = item & 31, kvh = (item >> 5) & 3, b = item >> 7;
    const int t0 = tb * 64, l15 = lane & 15, g = lane >> 4;
    const bf16_t* qkv = (const bf16_t*)(P.ws + WS_QKVA) + (size_t)b * SEQ * 2560;
    bf16_t* hoa = (bf16_t*)P.out;
#pragma unroll
    for (int i = 0; i < 3; ++i) {
        const int id = tid + 512 * i, row = id >> 3, dc = id & 7, tok = t0 - 128 + row;
        u32x4 kv = (u32x4){0u, 0u, 0u, 0u}, vv = kv;
        if (tok >= 0) { const bf16_t* p = qkv + (size_t)tok * 2560 + 2048 + kvh * 64 + dc * 8; kv = *(const u32x4*)p; vv = *(const u32x4*)(p + 256); }
        *(LAS u32x4*)(L + A_KA + row * 144 + dc * 16) = kv;
#pragma unroll
        for (int e = 0; e < 8; ++e) {
            const unsigned wv = vv[e >> 1]; const unsigned short val = (unsigned short)((e & 1) ? (wv >> 16) : (wv & 0xffffu));
            *(LAS unsigned short*)(L + A_VT + (dc * 8 + e) * 400 + row * 2) = val;
        }
    }
    lds_barrier();
    const int head = kvh * 8 + wave;
    const float sink = P.sinks[head];
    const int A_OT = 53248 + wave * 2304;
    const int otok = lane >> 2, och = lane & 3;
    for (int a = 0; a < 4; ++a) {
        const bf16_t* qp = qkv + (size_t)(t0 + 16 * a + l15) * 2560 + head * 64 + 8 * g;
        const bf16x8 q0 = *(const bf16x8*)qp, q1 = *(const bf16x8*)(qp + 32);
        bf16_t* zp = hoa + (size_t)(b * SEQ + t0 + 16 * a + otok) * 4096 + 2048 + head * 64 + 16 * och;
        const u32x4 zz0 = *(const u32x4*)zp, zz1 = *(const u32x4*)(zp + 8);
        f32x4 s[9];
#pragma unroll
        for (int i = 0; i < 9; ++i) {
            const int ko = A_KA + (16 * (a + i) + l15) * 144 + 16 * g;
            f32x4 z = (f32x4){0.f, 0.f, 0.f, 0.f};
            z = mfma32(lds16(L, ko), q0, z); z = mfma32(lds16(L, ko + 64), q1, z); s[i] = z;
        }
        const int qi = 16 * a + l15;
        float m = -INFINITY;
#pragma unroll
        for (int i = 0; i < 9; ++i)
#pragma unroll
            for (int j = 0; j < 4; ++j) {
                const int kk = 16 * (a + i) + 4 * g + j;
                const bool valid = (kk > qi) && (kk <= qi + 128) && (t0 - 128 + kk >= 0);
                const float sv = valid ? s[i][j] * 0.125f : -INFINITY;
                s[i][j] = sv; m = fmaxf(m, sv);
            }
        m = fmaxf(m, __shfl_xor(m, 16)); m = fmaxf(m, __shfl_xor(m, 32)); m = fmaxf(m, sink);
        float sum = 0.f;
#pragma unroll
        for (int i = 0; i < 9; ++i)
#pragma unroll
            for (int j = 0; j < 4; ++j) { const float p = __expf(s[i][j] - m); s[i][j] = p; sum += p; }
        sum += __shfl_xor(sum, 16); sum += __shfl_xor(sum, 32);
        const float inv = 1.f / (sum + __expf(sink - m));
        f32x4 o[4];
#pragma unroll
        for (int dt = 0; dt < 4; ++dt) o[dt] = (f32x4){0.f, 0.f, 0.f, 0.f};
#pragma unroll
        for (int i = 0; i < 9; ++i) {
            const bf16x4 pa = pack4(s[i][0] * inv, s[i][1] * inv, s[i][2] * inv, s[i][3] * inv);
#pragma unroll
            for (int dt = 0; dt < 4; ++dt) o[dt] = mfma16(pa, lds8(L, A_VT + (16 * dt + l15) * 400 + (16 * (a + i) + 4 * g) * 2), o[dt]);
        }
#pragma unroll
        for (int j = 0; j < 4; ++j)
#pragma unroll
            for (int dt = 0; dt < 4; ++dt)
                *(LAS unsigned short*)(L + A_OT + (4 * g + j) * 144 + (16 * dt + l15) * 2) = (unsigned short)(pk_bf16(o[dt][j], 0.f) & 0xffffu);
        asm volatile("s_waitcnt lgkmcnt(0)" ::: "memory");
        {
            const u32x4 o0 = *(const LAS u32x4*)(L + A_OT + otok * 144 + och * 32), o1 = *(const LAS u32x4*)(L + A_OT + otok * 144 + och * 32 + 16);
            u32x4 w0, w1;
#pragma unroll
            for (int e = 0; e < 4; ++e) {
                w0[e] = pk_bf16(bflo(o0[e]) * siluf_(bflo(zz0[e])), bfhi(o0[e]) * siluf_(bfhi(zz0[e])));
                w1[e] = pk_bf16(bflo(o1[e]) * siluf_(bflo(zz1[e])), bfhi(o1[e]) * siluf_(bfhi(zz1[e])));
            }
            bf16_t* op = dry ? ((bf16_t*)(P.ws + WS_WIN_T) + ((size_t)(zp - hoa) & 0x1fffff0u)) : zp;
            *(u32x4*)op = w0; *(u32x4*)(op + 8) = w1;
        }
        asm volatile("s_waitcnt lgkmcnt(0)" ::: "memory");
    }
    lds_barrier();
}

constexpr int PKV = 288;
constexpr int D_QS = 0, D_KS = 17408, D_WL = 35840, D_VS = 53248, D_AB = 71680, D_MT = 80896, D_TB = 90112, D_TBG = 99328, D_QKM = 108544,
              D_XB = 117760, D_YB = 126976, D_YTB = 136192, D_GC = 145408, D_BETA = 145664, D_EG = 145920, D_RED = 146176, D_CW = 148224;
static_assert(D_CW + 6144 <= LDS_BYTES, "lds");

template <bool DO_X, bool DO_Y, bool DO_YROW>
DI void neu_step(LAS unsigned char* L, int xin, int yin, int ytin, int xout, int yout, int ytout, f32x4& xacc, int ti, int tj, int blk, int l15, int g) {
    const int ra = (16 * ti + l15) * 144 + 16 * g + blk * 64, rb = (16 * tj + l15) * 144 + 16 * g + blk * 64;
    const int wo = (16 * tj + l15) * 144 + (16 * ti + 4 * g) * 2;
    const f32x4 z = (f32x4){0.f, 0.f, 0.f, 0.f};
    const bf16x8 yta = lds16(L, ytin + ra);
    if (DO_Y) {
        const f32x4 y = mfma32(lds16(L, yin + ra), lds16(L, ytin + rb), z);
        st8(L, ytout + wo, pack4(y[0], y[1], y[2], y[3]));
        if (DO_YROW) {
            const f32x4 yt = mfma32(yta, lds16(L, yin + rb), z);
            st8(L, yout + wo, pack4(yt[0], yt[1], yt[2], yt[3]));
        }
    }
    if (DO_X) {
        const f32x4 x = mfma32(yta, lds16(L, xin + rb), xacc);
        xacc = x;
        st8(L, xout + wo, pack4(x[0], x[1], x[2], x[3]));
    }
}

DI void deltanet_seq(const Params& P, LAS unsigned char* L, int seq, int tid, int wave, int lane, int dry = 0) {
    const int vh = seq & 31, b = seq >> 5, kh = vh >> 1;
    const int l15 = lane & 15, g = lane >> 4;
    const bf16_t* dqkv = (const bf16_t*)(P.ws + WS_DQKV) + (size_t)b * SEQ * 8192;
    bf16_t* dz = (bf16_t*)(P.ws + WS_DZ) + (size_t)b * SEQ * 4096 + vh * 128;
    const float* garr = (const float*)(P.ws + WS_G) + (size_t)b * SEQ * 32 + vh;
    const float* barr = (const float*)(P.ws + WS_BETA) + (size_t)b * SEQ * 32 + vh;
    LAS float* GC = (LAS float*)(L + D_GC); LAS float* BETA = (LAS float*)(L + D_BETA); LAS float* EG = (LAS float*)(L + D_EG);
    LAS float* RED = (LAS float*)(L + D_RED); LAS float* CW = (LAS float*)(L + D_CW);
    const int cbq = kh * 128, cbk = 2048 + kh * 128, cbv = 4096 + vh * 128;
    for (int i = tid; i < 1536; i += 512) { const int X = i >> 9, tap = (i >> 7) & 3, ch = i & 127; const int cb = X == 0 ? cbq : (X == 1 ? cbk : cbv); CW[i] = P.conv_w[(size_t)tap * 8192 + cb + ch]; }
    const float dnw = P.dn_norm_w[16 * wave + l15];
    f32x4 Sacc[8];
#pragma unroll
    for (int i = 0; i < 8; ++i) Sacc[i] = (f32x4){0.f, 0.f, 0.f, 0.f};
    lds_barrier();

    LAS unsigned char* const L0 = L;
    for (int n = 0; n < 32; ++n) {
        const int t0 = n * 64;
        int lz = 0; asm volatile("" : "+v"(lz));
        LAS unsigned char* const L = L0 + lz;
        LAS float* GC = (LAS float*)(L + D_GC); LAS float* BETA = (LAS float*)(L + D_BETA); LAS float* EG = (LAS float*)(L + D_EG);
        LAS float* RED = (LAS float*)(L + D_RED); LAS float* CW = (LAS float*)(L + D_CW);
        {
            asm volatile("" ::: "memory");
            const int grp = tid & 15, tokb = tid >> 4;
            const int c0 = 2 * tokb;
            u32x4 rawx[3][5];
#pragma unroll
            for (int X = 0; X < 3; ++X) {
                const int cb = (X == 0 ? cbq : (X == 1 ? cbk : cbv)) + grp * 8;
#pragma unroll
                for (int r = 0; r < 5; ++r) { const int tt = t0 + c0 - 3 + r; rawx[X][r] = (tt >= 0) ? *(const u32x4*)(dqkv + (size_t)tt * 8192 + cb) : (u32x4){0u, 0u, 0u, 0u}; }
            }
#pragma unroll
            for (int X = 0; X < 3; ++X) {
                float accA[8], accB[8];
#pragma unroll
                for (int e = 0; e < 8; ++e) { accA[e] = 0.f; accB[e] = 0.f; }
#pragma unroll
                for (int tap = 0; tap < 4; ++tap) {
                    const f32x4 w0 = *(const LAS f32x4*)(CW + (X * 4 + tap) * 128 + grp * 8), w1 = *(const LAS f32x4*)(CW + (X * 4 + tap) * 128 + grp * 8 + 4);
                    const u32x4 u = rawx[X][tap], v = rawx[X][tap + 1];
                    accA[0] += w0[0] * bflo(u.x); accA[1] += w0[1] * bfhi(u.x); accA[2] += w0[2] * bflo(u.y); accA[3] += w0[3] * bfhi(u.y);
                    accA[4] += w1[0] * bflo(u.z); accA[5] += w1[1] * bfhi(u.z); accA[6] += w1[2] * bflo(u.w); accA[7] += w1[3] * bfhi(u.w);
                    accB[0] += w0[0] * bflo(v.x); accB[1] += w0[1] * bfhi(v.x); accB[2] += w0[2] * bflo(v.y); accB[3] += w0[3] * bfhi(v.y);
                    accB[4] += w1[0] * bflo(v.z); accB[5] += w1[1] * bfhi(v.z); accB[6] += w1[2] * bflo(v.w); accB[7] += w1[3] * bfhi(v.w);
                }
                float ssA = 0.f, ssB = 0.f;
#pragma unroll
                for (int e = 0; e < 8; ++e) { accA[e] = siluf_(accA[e]); ssA += accA[e] * accA[e]; accB[e] = siluf_(accB[e]); ssB += accB[e] * accB[e]; }
                if (X < 2) {
                    ssA = sum16(ssA); ssB = sum16(ssB);
                    const float sc = (X == 0 ? 0.08838834764831845f : 1.f);
                    const float rA = rsqrtf(ssA + 1e-6f) * sc, rB = rsqrtf(ssB + 1e-6f) * sc;
#pragma unroll
                    for (int e = 0; e < 8; ++e) { accA[e] *= rA; accB[e] *= rB; }
                }
                u32x4 wA, wB;
                wA.x = pk_bf16(accA[0], accA[1]); wA.y = pk_bf16(accA[2], accA[3]); wA.z = pk_bf16(accA[4], accA[5]); wA.w = pk_bf16(accA[6], accA[7]);
                wB.x = pk_bf16(accB[0], accB[1]); wB.y = pk_bf16(accB[2], accB[3]); wB.z = pk_bf16(accB[4], accB[5]); wB.w = pk_bf16(accB[6], accB[7]);
                const int pit = (X == 0 ? 272 : PKV);
                const int base = (X == 0 ? D_QS : (X == 1 ? D_KS : D_VS)) + c0 * pit + grp * 16;
                *(LAS u32x4*)(L + base) = wA; *(LAS u32x4*)(L + base + pit) = wB;
            }
            if (wave == 0) {
                float gv = garr[(size_t)(t0 + lane) * 32];
#pragma unroll
                for (int d = 1; d < 64; d <<= 1) { const float o = __shfl_up(gv, d); if (lane >= d) gv += o; }
                GC[lane] = gv; EG[lane] = __expf(gv); BETA[lane] = barr[(size_t)(t0 + lane) * 32];
            }
        }
        lds_barrier();
        const int blk = wave >> 2, ti0 = 2 * blk + ((wave >> 1) & 1), tj0 = 2 * blk + (wave & 1), tj1 = 2 * (1 - blk) + (wave & 1);
        f32x4 xacc;
        {
#pragma unroll
        for (int tt = 0; tt < 2; ++tt) {
            const int ti = ti0, tj = tt ? tj1 : tj0;
            const int ra = D_KS + (16 * ti + l15) * PKV + 16 * g, rb = D_KS + (16 * tj + l15) * PKV + 16 * g, rq = D_QS + (16 * tj + l15) * 272 + 16 * g;
            f32x4 kk = (f32x4){0.f, 0.f, 0.f, 0.f}, qk = kk;
#pragma unroll
            for (int ks = 0; ks < 4; ++ks) {
                const bf16x8 ka = lds16(L, ra + ks * 64);
                kk = mfma32(ka, lds16(L, rb + ks * 64), kk);
                qk = mfma32(ka, lds16(L, rq + ks * 64), qk);
            }
            const int c = 16 * tj + l15; const float gc_c = GC[c], be_c = BETA[c];
            float xa[4], ya[4], yta[4], qm[4];
#pragma unroll
            for (int j = 0; j < 4; ++j) {
                const int r = 16 * ti + 4 * g + j; const float gc_r = GC[r], be_r = BETA[r];
                const float dcr = __expf(fminf(gc_c - gc_r, 0.f)), drc = __expf(fminf(gc_r - gc_c, 0.f));
                const float a_cr = (c > r) ? be_c * kk[j] * dcr : 0.f;
                const float a_rc = (r > c) ? be_r * kk[j] * drc : 0.f;
                xa[j] = ((c == r) ? 1.f : 0.f) - a_cr; ya[j] = a_cr; yta[j] = a_rc;
                qm[j] = (c >= r) ? qk[j] * dcr : 0.f;
            }
            if (tt == 0) xacc = (f32x4){xa[0], xa[1], xa[2], xa[3]};
            const int wo = (16 * tj + l15) * 144 + (16 * ti + 4 * g) * 2;
            st8(L, D_XB + wo, pack4(xa[0], xa[1], xa[2], xa[3]));
            st8(L, D_YB + wo, pack4(ya[0], ya[1], ya[2], ya[3]));
            st8(L, D_AB + wo, pack4(ya[0], ya[1], ya[2], ya[3]));
            st8(L, D_YTB + wo, pack4(yta[0], yta[1], yta[2], yta[3]));
            st8(L, D_QKM + wo, pack4(qm[0], qm[1], qm[2], qm[3]));
        }
        lds_barrier();
        neu_step<false, true, true>(L, 0, D_YB, D_YTB, 0, D_TBG, D_WL, xacc, ti0, tj0, blk, l15, g);
        lds_barrier();
        neu_step<true, true, true>(L, D_XB, D_TBG, D_WL, D_TB, D_YB, D_YTB, xacc, ti0, tj0, blk, l15, g);
        lds_barrier();
        neu_step<true, true, true>(L, D_TB, D_YB, D_YTB, D_XB, D_TBG, D_WL, xacc, ti0, tj0, blk, l15, g);
        lds_barrier();
        neu_step<true, true, false>(L, D_XB, D_TBG, D_WL, D_TB, 0, D_YTB, xacc, ti0, tj0, blk, l15, g);
        lds_barrier();
        neu_step<true, false, false>(L, D_TB, 0, D_YTB, D_XB, 0, 0, xacc, ti0, tj0, blk, l15, g);
        lds_barrier();
        {
            const int wo0 = (16 * tj0 + l15) * 144 + (16 * ti0 + 4 * g) * 2;
            const LAS float* be = BETA + 16 * ti0 + 4 * g; const LAS float* eg = EG + 16 * ti0 + 4 * g;
            const float t0 = xacc[0] * be[0], t1 = xacc[1] * be[1], t2 = xacc[2] * be[2], t3 = xacc[3] * be[3];
            st8(L, D_TB + wo0, pack4(t0, t1, t2, t3));
            st8(L, D_TBG + wo0, pack4(t0 * eg[0], t1 * eg[1], t2 * eg[2], t3 * eg[3]));
        }
        const int ct2 = 2 + ((wave >> 1) & 1), rt2 = wave & 1;
        if (wave < 4) {
            const bf16x8 aa = lds16(L, D_AB + (16 * ct2 + l15) * 144 + 16 * g);
            const int tq = D_XB + (8 * g + (l15 >> 2)) * 144 + (16 * rt2 + 4 * (l15 & 3)) * 2;
            const bf16x8 tb = cat8(lds_tr(L, tq), lds_tr(L, tq + 4 * 144));
            const f32x4 m = mfma32(aa, tb, (f32x4){0.f, 0.f, 0.f, 0.f});
            st8(L, D_MT + (16 * rt2 + l15) * 144 + (16 * (ct2 - 2) + 4 * g) * 2, pack4(m[0], m[1], m[2], m[3]));
        } else {
            const int zo = (16 * ((wave >> 1) & 1) + l15) * 144 + (16 * (2 + (wave & 1)) + 4 * g) * 2;
            st8(L, D_TB + zo, pack4(0.f, 0.f, 0.f, 0.f)); st8(L, D_TBG + zo, pack4(0.f, 0.f, 0.f, 0.f));
        }
        lds_barrier();
        if (wave < 4) {
            const f32x4 t = mfma32(lds16(L, D_MT + (16 * rt2 + l15) * 144 + 16 * g), lds16(L, D_XB + (16 * ct2 + l15) * 144 + 64 + 16 * g), (f32x4){0.f, 0.f, 0.f, 0.f});
            const LAS float* be = BETA + 16 * rt2 + 4 * g; const LAS float* eg = EG + 16 * rt2 + 4 * g;
            const float t0 = -t[0] * be[0], t1 = -t[1] * be[1], t2 = -t[2] * be[2], t3 = -t[3] * be[3];
            const int wo2 = (16 * ct2 + l15) * 144 + (16 * rt2 + 4 * g) * 2;
            st8(L, D_TB + wo2, pack4(t0, t1, t2, t3));
            st8(L, D_TBG + wo2, pack4(t0 * eg[0], t1 * eg[1], t2 * eg[2], t3 * eg[3]));
        }
        lds_barrier();
        }
        bf16_t* zrow = dz + (size_t)(t0 + (tid >> 3)) * 4096 + (tid & 7) * 16;
        const u32x4 zz0 = *(const u32x4*)zrow, zz1 = *(const u32x4*)(zrow + 8);
        f32x4 vn[4];
#pragma unroll
        for (int ct = 0; ct < 4; ++ct) {
            const int rt = (16 * ct + l15) * 144 + 16 * g;
            const int tq = (8 * g + (l15 >> 2)) * PKV + (16 * wave + 4 * (l15 & 3)) * 2;
            f32x4 u = (f32x4){0.f, 0.f, 0.f, 0.f}, wt = u;
#pragma unroll
            for (int ks = 0; ks < 2; ++ks) {
                const bf16x8 vb = cat8(lds_tr(L, D_VS + tq + ks * 32 * PKV), lds_tr(L, D_VS + tq + ks * 32 * PKV + 4 * PKV));
                const bf16x8 ka = cat8(lds_tr(L, D_KS + tq + ks * 32 * PKV), lds_tr(L, D_KS + tq + ks * 32 * PKV + 4 * PKV));
                u = mfma32(lds16(L, D_TB + rt + ks * 64), vb, u);
                wt = mfma32(ka, lds16(L, D_TBG + rt + ks * 64), wt);
            }
            vn[ct] = u;
            st8(L, D_WL + (16 * ct + l15) * 272 + (16 * wave + 4 * g) * 2, pack4(wt[0], wt[1], wt[2], wt[3]));
        }
        lds_barrier();
        f32x4 oq[4];
        {
            bf16x8 sb[4];
#pragma unroll
            for (int kb = 0; kb < 4; ++kb) sb[kb] = pack8(Sacc[2 * kb], Sacc[2 * kb + 1]);
#pragma unroll
            for (int ct = 0; ct < 4; ++ct) {
                f32x4 ws = (f32x4){0.f, 0.f, 0.f, 0.f}, qs = ws;
#pragma unroll
                for (int kb = 0; kb < 4; ++kb) {
                    ws = mfma32(lds_perm(L, D_WL + (16 * ct + l15) * 272 + (32 * kb + 4 * g) * 2), sb[kb], ws);
                    qs = mfma32(lds_perm(L, D_QS + (16 * ct + l15) * 272 + (32 * kb + 4 * g) * 2), sb[kb], qs);
                }
                vn[ct] = vn[ct] - ws;
#pragma unroll
                for (int j = 0; j < 4; ++j) qs[j] *= EG[16 * ct + 4 * g + j];
                oq[ct] = qs;
            }
        }
        {
            const bf16x8 vb0 = pack8(vn[0], vn[1]), vb1 = pack8(vn[2], vn[3]);
#pragma unroll
            for (int ct = 0; ct < 4; ++ct) {
                const int ro = D_QKM + (16 * ct + l15) * 144 + (4 * g) * 2;
                oq[ct] = mfma32(lds_perm(L, ro), vb0, oq[ct]);
                oq[ct] = mfma32(lds_perm(L, ro + 64), vb1, oq[ct]);
            }
            const float gl = GC[63], egl = __expf(gl);
            f32x4 vs[4];
#pragma unroll
            for (int ct = 0; ct < 4; ++ct)
#pragma unroll
                for (int j = 0; j < 4; ++j) vs[ct][j] = vn[ct][j] * __expf(gl - GC[16 * ct + 4 * g + j]);
            const bf16x8 sb0 = pack8(vs[0], vs[1]), sb1 = pack8(vs[2], vs[3]);
#pragma unroll
            for (int dk = 0; dk < 8; ++dk) {
                const int tk = D_KS + (4 * g + (l15 >> 2)) * PKV + (16 * dk + 4 * (l15 & 3)) * 2;
                f32x4 s = Sacc[dk] * egl;
                s = mfma32(cat8(lds_tr(L, tk), lds_tr(L, tk + 16 * PKV)), sb0, s);
                s = mfma32(cat8(lds_tr(L, tk + 32 * PKV), lds_tr(L, tk + 48 * PKV)), sb1, s);
                Sacc[dk] = s;
            }
        }
#pragma unroll
        for (int ct = 0; ct < 4; ++ct)
#pragma unroll
            for (int j = 0; j < 4; ++j) {
                const float ss = sum16(oq[ct][j] * oq[ct][j]);
                if (l15 == 0) RED[(16 * ct + 4 * g + j) * 8 + wave] = ss;
            }
        lds_barrier();
#pragma unroll
        for (int ct = 0; ct < 4; ++ct)
#pragma unroll
            for (int j = 0; j < 4; ++j) {
                const int c = 16 * ct + 4 * g + j;
                const f32x4 r0 = *(const LAS f32x4*)(RED + c * 8), r1 = *(const LAS f32x4*)(RED + c * 8 + 4);
                const float tot = r0[0] + r0[1] + r0[2] + r0[3] + r1[0] + r1[1] + r1[2] + r1[3];
                const float rs = rsqrtf(tot * (1.f / 128.f) + 1e-6f);
                *(LAS unsigned short*)(L + D_XB + c * 272 + (16 * wave + l15) * 2) = (unsigned short)(pk_bf16(oq[ct][j] * rs * dnw, 0.f) & 0xffffu);
            }
        lds_barrier();
        {
            const u32x4 o0 = *(const LAS u32x4*)(L + D_XB + (tid >> 3) * 272 + (tid & 7) * 32), o1 = *(const LAS u32x4*)(L + D_XB + (tid >> 3) * 272 + (tid & 7) * 32 + 16);
            u32x4 w0, w1;
#pragma unroll
            for (int e = 0; e < 4; ++e) {
                w0[e] = pk_bf16(bflo(o0[e]) * siluf_(bflo(zz0[e])), bfhi(o0[e]) * siluf_(bfhi(zz0[e])));
                w1[e] = pk_bf16(bflo(o1[e]) * siluf_(bflo(zz1[e])), bfhi(o1[e]) * siluf_(bfhi(zz1[e])));
            }
            bf16_t* op = dry ? ((bf16_t*)(P.ws + WS_WIN_T) + ((size_t)(zrow - (bf16_t*)(P.ws + WS_DZ)) & 0x1fffff0u)) : zrow;
            *(u32x4*)op = w0; *(u32x4*)(op + 8) = w1;
        }
    }
    lds_barrier();
}


#define XB_TMO      128
#define XB_XCNT(j)  (256  + 64 * (j))
#define XB_XSUB(j)  (1280 + 64 * (j))
#define XB_XGEN(j)  (2304 + 64 * (j))
#define XB_TOP      3328
#define XB_TOPGEN   3392
#define XCD_BAR_WORDS 3456
#define XB_SPIN_CAP (1u << 18)
DI unsigned xb_ld(unsigned* p)              { return __hip_atomic_load(p, __ATOMIC_RELAXED, __HIP_MEMORY_SCOPE_AGENT); }
DI unsigned xb_add(unsigned* p, unsigned v) { return __hip_atomic_fetch_add(p, v, __ATOMIC_RELAXED, __HIP_MEMORY_SCOPE_AGENT); }
DI unsigned xb_xcc_id() { return (unsigned)__builtin_amdgcn_s_getreg((3 << 11) | 20) & 0xFu; }
#define XB_SPIN(cond, bar) do { unsigned _sp = 0; while (cond) { __builtin_amdgcn_s_sleep(1); \
    if ((++_sp & 255u) == 0u) { if (xb_ld(&(bar)[XB_TMO])) break; if (_sp > XB_SPIN_CAP) { atomicAdd(&(bar)[XB_TMO], 1u); break; } } } } while (0)
struct XcdBarrier { unsigned* bar; unsigned x; volatile LAS unsigned* st; };
DI XcdBarrier xcd_barrier_post(unsigned* bar, volatile LAS unsigned* st) {
    XcdBarrier b; b.bar = bar; b.x = xb_xcc_id(); b.st = st;
    if (threadIdx.x == 0) (void)xb_add(&bar[XB_XCNT(b.x)], 1u);
    return b;
}
DI void xcd_barrier_complete(unsigned* bar, unsigned x, unsigned& nloc, unsigned& nx) {
    const unsigned G = gridDim.x * gridDim.y * gridDim.z;
    unsigned sum, cnt, mine, sp = 0u;
    for (;;) {
        sum = 0u; cnt = 0u; mine = 0u;
#pragma unroll
        for (unsigned j = 0; j < 16; ++j) { const unsigned c = xb_ld(&bar[XB_XCNT(j)]); sum += c; cnt += (c > 0u) ? 1u : 0u; mine = (j == x) ? c : mine; }
        if (sum == G) break;
        __builtin_amdgcn_s_sleep(1);
        if ((++sp & 255u) == 0u) { if (xb_ld(&bar[XB_TMO])) break; if (sp > XB_SPIN_CAP) { atomicAdd(&bar[XB_TMO], 1u); break; } }
    }
    nloc = mine > 0u ? mine : 1u; nx = cnt > 0u ? cnt : 1u;
}
DI void xcd_barrier(const XcdBarrier& b) {
    asm volatile("s_waitcnt vmcnt(0)" ::: "memory");
    __syncthreads();
    if (threadIdx.x == 0) {
        unsigned* bar = b.bar;
        __builtin_amdgcn_s_waitcnt(0);
        unsigned nloc = b.st[0], nx = b.st[1];
        if (nloc == 0u) { xcd_barrier_complete(bar, b.x, nloc, nx); b.st[0] = nloc; b.st[1] = nx; }
        const unsigned old = xb_add(&bar[XB_XSUB(b.x)], 1u);
        const unsigned gen = old / nloc;
        if (old + 1u == (gen + 1u) * nloc) {
            __builtin_amdgcn_fence(__ATOMIC_RELEASE, "agent");
            asm volatile("s_waitcnt vmcnt(0)" ::: "memory");
            const unsigned og = xb_add(&bar[XB_TOP], 1u);
            const unsigned tg = og / nx;
            if (og + 1u == (tg + 1u) * nx) xb_add(&bar[XB_TOPGEN], 1u);
            else XB_SPIN(xb_ld(&bar[XB_TOPGEN]) == tg, bar);
            __builtin_amdgcn_fence(__ATOMIC_ACQUIRE, "agent");
            xb_add(&bar[XB_XGEN(b.x)], 1u);
            asm volatile("s_waitcnt vmcnt(0)" ::: "memory");
        } else {
            XB_SPIN(xb_ld(&bar[XB_XGEN(b.x)]) == gen, bar);
            __builtin_amdgcn_fence(__ATOMIC_ACQUIRE, "agent");
            asm volatile("s_waitcnt vmcnt(0)" ::: "memory");
        }
    }
    __syncthreads();
}

__global__ void __launch_bounds__(512, 2) fwd_megakernel(Params P) {
    extern __shared__ __attribute__((aligned(16))) unsigned char lds_raw[];
    LAS unsigned char* L = (LAS unsigned char*)lds_raw;
    cg::grid_group grid = cg::this_grid();
#define FRESH_IDS const int tid = fresh_tid(), lane = tid & 63, wave = __builtin_amdgcn_readfirstlane(tid >> 6)
    const int G = gridDim.x, c = blockIdx.x;
    unsigned* const bar = (unsigned*)(P.ws + WS_BAR);
    {
        if (threadIdx.x == 0) { *(volatile LAS unsigned*)(L + LDS_BYTES - 16) = 0u; *(volatile LAS unsigned*)(L + LDS_BYTES - 12) = 0u; }
        __syncthreads();
    }
    const XcdBarrier xb = xcd_barrier_post(bar, (volatile LAS unsigned*)(L + LDS_BYTES - 16));
    if (P.ws == nullptr) grid.sync();
    bf16_t* hoa = (bf16_t*)P.out;

#ifndef PH_MASK
#define PH_MASK 0xFF
#endif
    if (PH_MASK & 1) { FRESH_IDS; phase_prologue(P, L, tid, wave, lane); }
    xcd_barrier(xb);
    if (PH_MASK & 2) {
        Sched1 S{(const char*)hoa, (const char*)(P.ws + WS_WIN_T), G, c};
        Epi1 E{(bf16_t*)(P.ws + WS_QKVA), hoa, (bf16_t*)(P.ws + WS_DQKV), (bf16_t*)(P.ws + WS_DZ), (float*)(P.ws + WS_BETA), (float*)(P.ws + WS_G), P.b_qkv, P.a_log, P.dt_bias};
        pg8::gemm_phase<Epi1, Sched1>(L, 4096, 2048, S, E);
    }
    xcd_barrier(xb);
    if (PH_MASK & 4) { FRESH_IDS; for (int item = c; item < 1024; item += G) attn_item(P, L, item, tid, wave, lane); }
    if (PH_MASK & 8) { FRESH_IDS; for (int seq = c; seq < 256; seq += G) deltanet_seq(P, L, seq, tid, wave, lane); }
    xcd_barrier(xb);
    if (PH_MASK & 16) {
        Sched2 S{(const char*)hoa, (const char*)(P.ws + WS_DZ), (const char*)(P.ws + WS_W2A_T), (const char*)(P.ws + WS_W2B_T), (const char*)(P.ws + WS_WDN_T), G, c};
        Epi2 E{(bf16_t*)(P.ws + WS_QKVA), P.ws + WS_GSCR + (size_t)c * 131072};
        pg8::gemm_phase<Epi2, Sched2>(L, 4096, 4096, S, E);
    }
    xcd_barrier(xb);
    if (PH_MASK & 32) {
        Sched3 S{(const char*)(P.ws + WS_QKVA), (const char*)(P.ws + WS_WOUT_T), G, c};
        Epi3 E{P.x, P.out, (float*)(P.ws + WS_PART)};
        pg8::gemm_phase<Epi3, Sched3>(L, 2048, 2048, S, E);
    }
    xcd_barrier(xb);
    {
        FRESH_IDS;
        const float* part = (const float*)(P.ws + WS_PART);
        f32x4 fw[8];
#pragma unroll
        for (int i = 0; i < 8; ++i) fw[i] = *(const f32x4*)(P.final_w + (i * 64 + lane) * 4);
        for (int row = c * 8 + wave; row < MTOK; row += G * 16) {
            const int row2r = row + G * 8; const bool has2 = row2r < MTOK; const int row2 = has2 ? row2r : row;
            float ss = part[(size_t)row * 32 + (lane & 31)], ss2 = part[(size_t)row2 * 32 + (lane & 31)];
            float* o = P.out + (size_t)row * 2048; float* o2 = P.out + (size_t)row2 * 2048;
            f32x4 v[8], u[8];
#pragma unroll
            for (int i = 0; i < 8; ++i) { v[i] = *(const f32x4*)(o + (i * 64 + lane) * 4); u[i] = *(const f32x4*)(o2 + (i * 64 + lane) * 4); }
#pragma unroll
            for (int d = 1; d < 32; d <<= 1) { ss += __shfl_xor(ss, d); ss2 += __shfl_xor(ss2, d); }
            const float rs = rsqrtf(ss * (1.f / 2048.f) + 1e-6f), rs2 = rsqrtf(ss2 * (1.f / 2048.f) + 1e-6f);
#pragma unroll
            for (int i = 0; i < 8; ++i) {
                const f32x4 w = fw[i];
                f32x4 a = v[i]; a[0] *= rs * w[0]; a[1] *= rs * w[1]; a[2] *= rs * w[2]; a[3] *= rs * w[3];
                *(f32x4*)(o + (i * 64 + lane) * 4) = a;
                if (has2) { f32x4 q = u[i]; q[0] *= rs2 * w[0]; q[1] *= rs2 * w[1]; q[2] *= rs2 * w[2]; q[3] *= rs2 * w[3]; *(f32x4*)(o2 + (i * 64 + lane) * 4) = q; }
            }
        }
    }
}

extern "C" void kernel_launch(void* const* d_in, const int* in_sizes, int n_in, void* d_out, int out_size, void* d_ws, size_t ws_size, hipStream_t stream) {
    static int grid_blocks = 0;
    if (grid_blocks == 0) {
        if (ws_size < WS_END) { fprintf(stderr, "kernel_launch: workspace too small: %zu < %zu\n", ws_size, (size_t)WS_END); grid_blocks = -1; return; }
        int dev = 0, cus = 0, per_cu = 0;
        hipGetDevice(&dev);
        hipDeviceGetAttribute(&cus, hipDeviceAttributeMultiprocessorCount, dev);
        if (hipFuncSetAttribute((const void*)fwd_megakernel, hipFuncAttributeMaxDynamicSharedMemorySize, LDS_BYTES) != hipSuccess) { fprintf(stderr, "kernel_launch: hipFuncSetAttribute failed\n"); }
        if (hipOccupancyMaxActiveBlocksPerMultiprocessor(&per_cu, (const void*)fwd_megakernel, 512, LDS_BYTES) != hipSuccess || per_cu < 1) { fprintf(stderr, "kernel_launch: occupancy query gives %d\n", per_cu); per_cu = 1; }
        (void)hipGetLastError();
        grid_blocks = cus * per_cu;
        if (grid_blocks > 256) grid_blocks = 256;
    }
    if (grid_blocks < 0) return;
    Params p{};
    p.x = (const float*)d_in[0]; p.norm_w = (const float*)d_in[1]; p.w_in = (const float*)d_in[2]; p.b_qkv = (const float*)d_in[3];
    p.sinks = (const float*)d_in[4]; p.conv_w = (const float*)d_in[5]; p.a_log = (const float*)d_in[6]; p.dt_bias = (const float*)d_in[7];
    p.dn_norm_w = (const float*)d_in[8]; p.w_att = (const float*)d_in[9]; p.w_dn = (const float*)d_in[10]; p.w_out = (const float*)d_in[11];
    p.final_w = (const float*)d_in[12]; p.out = (float*)d_out; p.ws = (unsigned char*)d_ws;
    if (hipMemsetAsync((char*)d_ws + WS_BAR, 0, WS_BAR_BYTES, stream) != hipSuccess) { fprintf(stderr, "kernel_launch: memset of the barrier words failed\n"); return; }
    void* args[] = {&p};
    hipError_t e = hipLaunchCooperativeKernel((const void*)fwd_megakernel, dim3(grid_blocks), dim3(512), args, LDS_BYTES, stream);
    if (e != hipSuccess) fprintf(stderr, "cooperative launch failed: %s (grid %d)\n", hipGetErrorString(e), grid_blocks);
}
```

```cpp
#include <hip/hip_runtime.h>
#include <hip/hip_cooperative_groups.h>
#include <cstdio>
namespace cg = cooperative_groups;

#define LAS __attribute__((address_space(3)))
#define DI __device__ __forceinline__
typedef unsigned short bf16_t;
typedef short bf16x8 __attribute__((ext_vector_type(8)));
typedef short bf16x4 __attribute__((ext_vector_type(4)));
typedef float f32x4 __attribute__((ext_vector_type(4)));
typedef unsigned u32x4 __attribute__((ext_vector_type(4)));
typedef unsigned u32x2 __attribute__((ext_vector_type(2)));

constexpr int MTOK = 16384, DM = 2048, SEQ = 2048;
constexpr int N1 = 17152;
constexpr size_t MB = 1u << 20;
constexpr size_t WS_WIN_T = 0;
constexpr size_t WS_W2A_T = WS_WIN_T + (size_t)N1 * 2048 * 2;
constexpr size_t WS_W2B_T = WS_W2A_T + (size_t)2048 * 4096 * 2;
constexpr size_t WS_WDN_T = WS_W2B_T + (size_t)2048 * 4096 * 2;
constexpr size_t WS_WOUT_T = WS_WDN_T + (size_t)2048 * 4096 * 2;
constexpr size_t WS_QKVA = WS_WOUT_T + (size_t)2048 * 2048 * 2;
constexpr size_t WS_DQKV = WS_QKVA + (size_t)MTOK * 2560 * 2;
constexpr size_t WS_DZ = WS_DQKV + (size_t)MTOK * 8192 * 2;
constexpr size_t WS_BETA = WS_DZ + (size_t)MTOK * 4096 * 2;
constexpr size_t WS_G = WS_BETA + (size_t)MTOK * 32 * 4;
constexpr size_t WS_BAR = WS_G + (size_t)MTOK * 32 * 4;
constexpr size_t WS_BAR_BYTES = 16384;
constexpr size_t WS_END = WS_BAR + WS_BAR_BYTES;
constexpr size_t WS_GSCR = WS_DQKV;
constexpr size_t WS_PART = WS_DQKV + 64 * MB;

constexpr int LDS_BYTES = 153600;

struct Params {
    const float* x; const float* norm_w; const float* w_in; const float* b_qkv; const float* sinks; const float* conv_w;
    const float* a_log; const float* dt_bias; const float* dn_norm_w; const float* w_att; const float* w_dn; const float* w_out;
    const float* final_w; float* out; unsigned char* ws;
};

typedef __bf16 bf2_t __attribute__((ext_vector_type(2)));
typedef float f32x2 __attribute__((ext_vector_type(2)));
DI unsigned pk_bf16(float lo, float hi) { f32x2 v = {lo, hi}; bf2_t b = __builtin_convertvector(v, bf2_t); return __builtin_bit_cast(unsigned, b); }
DI int fresh_tid() { int t = threadIdx.x; asm volatile("" : "+v"(t)); return t; }
DI float bf2f(unsigned short b) { return __uint_as_float(((unsigned)b) << 16); }
DI float bflo(unsigned u) { return __uint_as_float(u << 16); }
DI float bfhi(unsigned u) { return __uint_as_float(u & 0xffff0000u); }
DI float sigmoidf_(float x) { return __builtin_amdgcn_rcpf(1.f + __expf(-x)); }
DI float siluf_(float x) { return x * sigmoidf_(x); }
DI f32x4 mfma32(bf16x8 a, bf16x8 b, f32x4 c) { return __builtin_amdgcn_mfma_f32_16x16x32_bf16(a, b, c, 0, 0, 0); }
DI f32x4 mfma16(bf16x4 a, bf16x4 b, f32x4 c) { return __builtin_amdgcn_mfma_f32_16x16x16bf16_1k(a, b, c, 0, 0, 0); }
DI bf16x4 pack4(float a, float b, float c, float d) { u32x2 w; w.x = pk_bf16(a, b); w.y = pk_bf16(c, d); return __builtin_bit_cast(bf16x4, w); }
DI bf16x8 pack8(f32x4 a, f32x4 b) { u32x4 w; w.x = pk_bf16(a[0], a[1]); w.y = pk_bf16(a[2], a[3]); w.z = pk_bf16(b[0], b[1]); w.w = pk_bf16(b[2], b[3]); return __builtin_bit_cast(bf16x8, w); }
DI bf16x8 lds16(LAS unsigned char* L, int off) { return *(const LAS bf16x8*)(L + off); }
DI bf16x4 lds8(LAS unsigned char* L, int off) { return *(const LAS bf16x4*)(L + off); }
DI bf16x8 lds_perm(LAS unsigned char* L, int off) {
    bf16x4 lo = *(const LAS bf16x4*)(L + off), hi = *(const LAS bf16x4*)(L + off + 32);
    return __builtin_shufflevector(lo, hi, 0, 1, 2, 3, 4, 5, 6, 7);
}
DI bf16x4 lds_tr(LAS unsigned char* L, int off) { return __builtin_amdgcn_ds_read_tr16_b64_v4i16((LAS bf16x4*)(L + off)); }
DI bf16x8 cat8(bf16x4 lo, bf16x4 hi) { return __builtin_shufflevector(lo, hi, 0, 1, 2, 3, 4, 5, 6, 7); }
DI float sum16(float v) {
    v += __builtin_bit_cast(float, __builtin_amdgcn_mov_dpp(__builtin_bit_cast(int, v), 0xB1, 0xf, 0xf, true));
    v += __builtin_bit_cast(float, __builtin_amdgcn_mov_dpp(__builtin_bit_cast(int, v), 0x4E, 0xf, 0xf, true));
    v += __builtin_bit_cast(float, __builtin_amdgcn_mov_dpp(__builtin_bit_cast(int, v), 0x141, 0xf, 0xf, true));
    v += __builtin_bit_cast(float, __builtin_amdgcn_mov_dpp(__builtin_bit_cast(int, v), 0x140, 0xf, 0xf, true));
    return v;
}
DI void lds_barrier() { asm volatile("s_waitcnt lgkmcnt(0)\n\ts_barrier" ::: "memory"); }
DI void st8(LAS unsigned char* L, int off, bf16x4 v) { *(LAS bf16x4*)(L + off) = v; }

namespace pg8 {
constexpr int BM = 256, BK = 64, HALF = 128, HTB = HALF * BK * 2, STAGE_BYTES = 8 * HTB, NXCD = 8, WGM = 8;
DI int lds_byte(int r, int c) { const int st = (r >> 4) * 2 + (c >> 5), rr = r & 15, cc = c & 31, ob = rr * 64 + cc * 2; return st * 1024 + (ob ^ (((ob >> 9) & 1) << 5)); }
DI void stage_rc(int b, int& R, int& C) { const int st = b / 1024, sb = b % 1024, swz = sb ^ (((sb >> 9) & 1) << 5); R = (st >> 1) * 16 + swz / 64; C = (st & 1) * 32 + (swz % 64) / 2; }
DI int perm32(int rho) { const int n = rho >> 4, i = rho & 15; return 8 * (i >> 2) + 4 * n + (i & 3); }

struct Unit { int pm, pn, tag, nt; const char* A; const char* B; };

DI void map_tile(int L, int nM, int nN, int& pm, int& pn) {
    const int nwg = nM * nN; int wgid = L;
    { const int q = nwg / NXCD, r = nwg % NXCD, xcd = wgid % NXCD, off = wgid / NXCD; wgid = (xcd < r ? xcd * (q + 1) : r * (q + 1) + (xcd - r) * q) + off; }
    const int nig = WGM * nN, gid = wgid / nig, fm = gid * WGM, gsz = (nM - fm) < WGM ? (nM - fm) : WGM;
    pm = fm + ((wgid % nig) % gsz); pn = (wgid % nig) / gsz;
}

template <class Epi, class Sched>
DI void gemm_phase(LAS unsigned char* lds, const int lda, const int ldb, const Sched& S, const Epi& E) {
    const int tid = fresh_tid(), wid = __builtin_amdgcn_readfirstlane(tid >> 6), lane = tid & 63, wr = wid >> 2, wc = wid & 3, fr = lane & 15, fq = lane >> 4;
    unsigned voffA[2], voffB[2];
#pragma unroll
    for (int i = 0; i < 2; ++i) { int R, C; stage_rc(tid * 16 + i * 8192, R, C); const int Rb = Epi::PERM ? ((R & ~31) + perm32(R & 31)) : R;
        voffA[i] = (unsigned)(R * lda + C) * 2u; voffB[i] = (unsigned)(Rb * ldb + C) * 2u; }
    const size_t kstep = (size_t)(BK * 2);
    const size_t hstepA = (size_t)HALF * lda * 2, hstepB = (size_t)HALF * ldb * 2;
    const unsigned ldsw = (unsigned)wid * 1024u;
    const int aoff = lds_byte(wr * 64 + fr, fq * 8), boff = lds_byte(wc * 32 + fr, fq * 8);
#define PG8_SA(b, h) (((b) * 2 + (h)) * HTB)
#define PG8_SB(b, h) ((4 + (b) * 2 + (h)) * HTB)
#define PG8_STAGE(bufoff, gbase, voff) do { _Pragma("unroll") for (int _i = 0; _i < 2; ++_i) \
        __builtin_amdgcn_global_load_lds((const unsigned*)((const char*)(gbase) + (voff)[_i]), (LAS unsigned*)(lds + (bufoff) + ldsw + _i * 8192), 16, 0, 0); } while (0)
#define PG8_LDA(dst, b, h) do { _Pragma("unroll") for (int m = 0; m < 4; ++m) _Pragma("unroll") for (int k = 0; k < 2; ++k) dst[m][k] = *(const LAS bf16x8*)(lds + PG8_SA(b, h) + aoff + m * 2048 + k * 1024); } while (0)
#define PG8_LDB(dst, b, h) do { _Pragma("unroll") for (int n = 0; n < 2; ++n) _Pragma("unroll") for (int k = 0; k < 2; ++k) dst[n][k] = *(const LAS bf16x8*)(lds + PG8_SB(b, h) + boff + n * 2048 + k * 1024); } while (0)
#define PG8_MMA(ai, bj, At, Bt) do { __builtin_amdgcn_s_setprio(1); _Pragma("unroll") for (int m = 0; m < 4; ++m) _Pragma("unroll") for (int n = 0; n < 2; ++n) _Pragma("unroll") for (int k = 0; k < 2; ++k) \
        acc[ai][bj][m][n] = __builtin_amdgcn_mfma_f32_16x16x32_bf16(Bt[n][k], At[m][k], acc[ai][bj][m][n], 0, 0, 0); __builtin_amdgcn_s_setprio(0); } while (0)
#define PG8_WAIT_V(n) asm volatile("s_waitcnt vmcnt(" #n ")" ::: "memory")
#define PG8_WAIT_L(n) asm volatile("s_waitcnt lgkmcnt(" #n ")" ::: "memory")
#define PG8_BAR __builtin_amdgcn_s_barrier()
#define PG8_SCHED __builtin_amdgcn_sched_barrier(0)
    Unit cur, nxt; int ui = 0;
    if (!S.next(0, cur)) return;
    f32x4 acc[2][2][4][2];
#pragma unroll
    for (int a = 0; a < 2; ++a)
#pragma unroll
        for (int b = 0; b < 2; ++b)
#pragma unroll
            for (int m = 0; m < 4; ++m)
#pragma unroll
                for (int n = 0; n < 2; ++n) acc[a][b][m][n] = (f32x4){0.f, 0.f, 0.f, 0.f};
    bf16x8 At[4][2], B0[2][2], B1[2][2];
    const char* cA = cur.A; const char* cB = cur.B;
    PG8_STAGE(PG8_SB(0, 0), cB, voffB); PG8_STAGE(PG8_SA(0, 0), cA, voffA); PG8_STAGE(PG8_SB(0, 1), cB + hstepB, voffB); PG8_STAGE(PG8_SA(0, 1), cA + hstepA, voffA);
    if (wr == 1) PG8_BAR;
    PG8_WAIT_V(4); PG8_BAR;
    PG8_STAGE(PG8_SB(1, 0), cB + kstep, voffB); PG8_STAGE(PG8_SA(1, 0), cA + kstep, voffA); PG8_STAGE(PG8_SB(1, 1), cB + hstepB + kstep, voffB);
    PG8_WAIT_V(6); PG8_BAR;
    for (;;) {
        const bool has_next = S.next(ui + 1, nxt);
        const char* nA = has_next ? nxt.A : cA; const char* nB = has_next ? nxt.B : cB;
        const int nt = cur.nt;
        for (int t = 0; t < nt; t += 2) {
            const bool last = (t == nt - 2);
            const char* a1 = cA + (size_t)(t + 1) * kstep;
            const char* a2 = last ? nA : cA + (size_t)(t + 2) * kstep; const char* b2 = last ? nB : cB + (size_t)(t + 2) * kstep;
            const char* a3 = a2 + kstep; const char* b3 = b2 + kstep;
            PG8_LDB(B0, 0, 0); PG8_SCHED; PG8_LDA(At, 0, 0); PG8_STAGE(PG8_SA(1, 1), a1 + hstepA, voffA);
            PG8_WAIT_L(8); PG8_BAR; PG8_WAIT_L(0); PG8_MMA(0, 0, At, B0); PG8_BAR; PG8_SCHED;
            PG8_LDB(B1, 0, 1); PG8_STAGE(PG8_SB(0, 0), b2, voffB);
            PG8_BAR; PG8_WAIT_L(0); PG8_MMA(0, 1, At, B1); PG8_BAR;
            PG8_LDA(At, 0, 1); PG8_STAGE(PG8_SA(0, 0), a2, voffA);
            PG8_BAR; PG8_WAIT_L(0); PG8_MMA(1, 0, At, B0); PG8_BAR; PG8_SCHED;
            PG8_STAGE(PG8_SB(0, 1), b2 + hstepB, voffB);
            PG8_WAIT_V(6); PG8_BAR; PG8_MMA(1, 1, At, B1); PG8_BAR;
            PG8_LDB(B0, 1, 0); PG8_SCHED; PG8_LDA(At, 1, 0); PG8_STAGE(PG8_SA(0, 1), a2 + hstepA, voffA);
            PG8_WAIT_L(8); PG8_BAR; PG8_WAIT_L(0); PG8_MMA(0, 0, At, B0); PG8_BAR; PG8_SCHED;
            PG8_LDB(B1, 1, 1); PG8_STAGE(PG8_SB(1, 0), b3, voffB);
            PG8_BAR; PG8_WAIT_L(0); PG8_MMA(0, 1, At, B1); PG8_BAR;
            PG8_LDA(At, 1, 1); PG8_STAGE(PG8_SA(1, 0), a3, voffA);
            PG8_BAR; PG8_WAIT_L(0); PG8_MMA(1, 0, At, B0); PG8_BAR; PG8_SCHED;
            PG8_STAGE(PG8_SB(1, 1), b3 + hstepB, voffB);
            PG8_WAIT_V(6); PG8_BAR; PG8_MMA(1, 1, At, B1); PG8_BAR;
        }
        E(acc, cur, wr, wc, fr, fq);
        if (!has_next) break;
#pragma unroll
        for (int a = 0; a < 2; ++a)
#pragma unroll
            for (int b = 0; b < 2; ++b)
#pragma unroll
                for (int m = 0; m < 4; ++m)
#pragma unroll
                    for (int n = 0; n < 2; ++n) acc[a][b][m][n] = (f32x4){0.f, 0.f, 0.f, 0.f};
        cur = nxt; cA = nA; cB = nB; ++ui;
    }
    PG8_WAIT_V(0);
    if (wr == 0) PG8_BAR;
    PG8_BAR;
#undef PG8_SA
#undef PG8_SB
#undef PG8_STAGE
#undef PG8_LDA
#undef PG8_LDB
#undef PG8_MMA
#undef PG8_WAIT_V
#undef PG8_WAIT_L
#undef PG8_BAR
#undef PG8_SCHED
}
}

struct Sched1 {
    const char* A; const char* B; int G, c;
    DI bool next(int i, pg8::Unit& u) const {
        const int L = i * G + c; if (L >= 64 * 67) return false;
        pg8::map_tile(L, 64, 67, u.pm, u.pn); u.tag = 0; u.nt = 32;
        u.A = A + (size_t)u.pm * 256 * 4096 * 2; u.B = B + (size_t)u.pn * 256 * 2048 * 2; return true;
    }
};
struct Epi1 {
    static constexpr bool PERM = true;
    bf16_t* qkva; bf16_t* hoa; bf16_t* dqkv; bf16_t* dz; float* beta; float* g; const float* b_qkv; const float* a_log; const float* dt_bias;
    DI void operator()(const f32x4 (&acc)[2][2][4][2], const pg8::Unit& u, int wr, int wc, int fr, int fq) const {
        const int pn = u.pn;
        const int row0 = u.pm * 256 + wr * 64 + fr;
        const int cl0 = wc * 32 + 8 * fq;
        if (pn == 66) {
            if (wc < 2) {
                const int hc = 8 * fq;
#pragma unroll
                for (int ai = 0; ai < 2; ++ai)
#pragma unroll
                    for (int m = 0; m < 4; ++m) {
                        const int row = row0 + ai * 128 + m * 16;
                        f32x4 v0 = acc[ai][0][m][0], v1 = acc[ai][0][m][1], o0, o1;
                        if (wc == 0) {
#pragma unroll
                            for (int j = 0; j < 4; ++j) { o0[j] = sigmoidf_(v0[j]); o1[j] = sigmoidf_(v1[j]); }
                            *(f32x4*)(beta + (size_t)row * 32 + hc) = o0; *(f32x4*)(beta + (size_t)row * 32 + hc + 4) = o1;
                        } else {
#pragma unroll
                            for (int j = 0; j < 4; ++j) {
                                float p0 = v0[j] + dt_bias[hc + j], p1 = v1[j] + dt_bias[hc + 4 + j];
                                float s0 = fmaxf(p0, 0.f) + log1pf(__expf(-fabsf(p0))), s1 = fmaxf(p1, 0.f) + log1pf(__expf(-fabsf(p1)));
                                o0[j] = -__expf(a_log[hc + j]) * s0; o1[j] = -__expf(a_log[hc + 4 + j]) * s1;
                            }
                            *(f32x4*)(g + (size_t)row * 32 + hc) = o0; *(f32x4*)(g + (size_t)row * 32 + hc + 4) = o1;
                        }
                    }
            }
            return;
        }
        bf16_t* base; int ld, colt, mode;
        if (pn < 10) { base = qkva; ld = 2560; colt = pn * 256; mode = 0; }
        else if (pn < 18) { base = hoa + 2048; ld = 4096; colt = (pn - 10) * 256; mode = 1; }
        else if (pn < 50) { base = dqkv; ld = 8192; colt = (pn - 18) * 256; mode = 2; }
        else { base = dz; ld = 4096; colt = (pn - 50) * 256; mode = 1; }
#pragma unroll
        for (int bj = 0; bj < 2; ++bj) {
            const int col = colt + bj * 128 + cl0;
            f32x4 b0 = (f32x4){0.f, 0.f, 0.f, 0.f}, b1 = b0;
            if (mode == 0) { b0 = *(const f32x4*)(b_qkv + col); b1 = *(const f32x4*)(b_qkv + col + 4); }
#pragma unroll
            for (int ai = 0; ai < 2; ++ai)
#pragma unroll
                for (int m = 0; m < 4; ++m) {
                    const int row = row0 + ai * 128 + m * 16;
                    f32x4 v0 = acc[ai][bj][m][0] + b0, v1 = acc[ai][bj][m][1] + b1;
                    u32x4 w; w.x = pk_bf16(v0[0], v0[1]); w.y = pk_bf16(v0[2], v0[3]); w.z = pk_bf16(v1[0], v1[1]); w.w = pk_bf16(v1[2], v1[3]);
                    *(u32x4*)(base + (size_t)row * ld + col) = w;
                }
        }
    }
};

struct Sched2 {
    const char* hoa; const char* od; const char* w2a; const char* w2b; const char* wdn; int G, c;
    DI bool next(int i, pg8::Unit& u) const {
        const int L = (i >> 2) * G + c; if (L >= 64 * 8) return false;
        pg8::map_tile(L, 64, 8, u.pm, u.pn); const int sub = i & 3; u.tag = sub;
        const size_t ao = (size_t)u.pm * 256 * 4096 * 2, bo = (size_t)u.pn * 256 * 4096 * 2;
        if (sub == 0) { u.A = hoa + ao; u.B = w2b + bo; u.nt = 32; }
        else if (sub == 1) { u.A = od + ao; u.B = wdn + bo; u.nt = 64; }
        else if (sub == 2) { u.A = hoa + ao; u.B = w2a + bo; u.nt = 32; }
        else { u.A = hoa + ao + 4096; u.B = w2a + bo + 4096; u.nt = 32; }
        return true;
    }
};
struct Epi2 {
    static constexpr bool PERM = true;
    bf16_t* merged; unsigned char* scr;
    DI void operator()(const f32x4 (&acc)[2][2][4][2], const pg8::Unit& u, int wr, int wc, int fr, int fq) const {
        const int tag = u.tag;
        const int row0 = u.pm * 256 + wr * 64 + fr, col0 = u.pn * 256 + wc * 32 + 8 * fq;
        unsigned char* __restrict__ const sbase = scr + (size_t)threadIdx.x * 16;
        bf16_t* __restrict__ const mbase = merged + (size_t)row0 * 2048 + col0;
        if ((tag & 1) == 0) {
#pragma unroll
            for (int ai = 0; ai < 2; ++ai)
#pragma unroll
                for (int m = 0; m < 4; ++m)
#pragma unroll
                    for (int bj = 0; bj < 2; ++bj) {
                        f32x4 v0 = acc[ai][bj][m][0], v1 = acc[ai][bj][m][1];
#pragma unroll
                        for (int j = 0; j < 4; ++j) { v0[j] = sigmoidf_(v0[j]); v1[j] = sigmoidf_(v1[j]); }
                        u32x4 w; w.x = pk_bf16(v0[0], v0[1]); w.y = pk_bf16(v0[2], v0[3]); w.z = pk_bf16(v1[0], v1[1]); w.w = pk_bf16(v1[2], v1[3]);
                        *(u32x4*)(sbase + (size_t)((ai * 4 + m) * 2 + bj) * 8192) = w;
                    }
            return;
        }
        asm volatile("s_waitcnt vmcnt(0)" ::: "memory");
#pragma unroll
        for (int aq = 0; aq < 4; ++aq) {
            const int ai = aq >> 1, m0 = (aq & 1) * 2;
            u32x4 gt[4][2], pv[4][2];
#pragma unroll
            for (int m = m0; m < m0 + 2; ++m)
#pragma unroll
                for (int bj = 0; bj < 2; ++bj) {
                    gt[m][bj] = *(const u32x4*)(sbase + (size_t)((ai * 4 + m) * 2 + bj) * 8192);
                    pv[m][bj] = (tag == 3) ? *(const u32x4*)(mbase + (size_t)(ai * 128 + m * 16) * 2048 + bj * 128) : (u32x4){0u, 0u, 0u, 0u};
                }
#pragma unroll
            for (int m = m0; m < m0 + 2; ++m)
#pragma unroll
                for (int bj = 0; bj < 2; ++bj) {
                    const f32x4 v0 = acc[ai][bj][m][0], v1 = acc[ai][bj][m][1];
                    const u32x4 g4 = gt[m][bj], p4 = pv[m][bj];
                    float o[8];
                    o[0] = bflo(g4.x) * v0[0] + bflo(p4.x); o[1] = bfhi(g4.x) * v0[1] + bfhi(p4.x); o[2] = bflo(g4.y) * v0[2] + bflo(p4.y); o[3] = bfhi(g4.y) * v0[3] + bfhi(p4.y);
                    o[4] = bflo(g4.z) * v1[0] + bflo(p4.z); o[5] = bfhi(g4.z) * v1[1] + bfhi(p4.z); o[6] = bflo(g4.w) * v1[2] + bflo(p4.w); o[7] = bfhi(g4.w) * v1[3] + bfhi(p4.w);
                    u32x4 w; w.x = pk_bf16(o[0], o[1]); w.y = pk_bf16(o[2], o[3]); w.z = pk_bf16(o[4], o[5]); w.w = pk_bf16(o[6], o[7]);
                    *(u32x4*)(mbase + (size_t)(ai * 128 + m * 16) * 2048 + bj * 128) = w;
                }
        }
    }
};

struct Sched3 {
    const char* A; const char* B; int G, c;
    DI bool next(int i, pg8::Unit& u) const {
        const int L = i * G + c; if (L >= 64 * 8) return false;
        pg8::map_tile(L, 64, 8, u.pm, u.pn); u.tag = 0; u.nt = 32;
        u.A = A + (size_t)u.pm * 256 * 2048 * 2; u.B = B + (size_t)u.pn * 256 * 2048 * 2; return true;
    }
};
struct Epi3 {
    static constexpr bool PERM = false;
    const float* x; float* out; float* part;
    DI void operator()(const f32x4 (&acc)[2][2][4][2], const pg8::Unit& u, int wr, int wc, int fr, int fq) const {
        const int row0 = u.pm * 256 + wr * 64 + fr, col0 = u.pn * 256 + wc * 32 + 4 * fq;
        const float* __restrict__ const xb = x + (size_t)row0 * 2048 + col0;
        float* __restrict__ const ob = out + (size_t)row0 * 2048 + col0;
#pragma unroll
        for (int aq = 0; aq < 4; ++aq) {
            const int ai = aq >> 1, m0 = (aq & 1) * 2;
            f32x4 xs[4][2][2];
#pragma unroll
            for (int m = m0; m < m0 + 2; ++m)
#pragma unroll
                for (int bj = 0; bj < 2; ++bj)
#pragma unroll
                    for (int n = 0; n < 2; ++n) xs[m][bj][n] = *(const f32x4*)(xb + (size_t)(ai * 128 + m * 16) * 2048 + bj * 128 + n * 16);
#pragma unroll
            for (int m = m0; m < m0 + 2; ++m) {
                const int row = row0 + ai * 128 + m * 16;
                float ss = 0.f;
#pragma unroll
                for (int bj = 0; bj < 2; ++bj)
#pragma unroll
                    for (int n = 0; n < 2; ++n) {
                        const f32x4 v = acc[ai][bj][m][n] + xs[m][bj][n];
                        *(f32x4*)(ob + (size_t)(ai * 128 + m * 16) * 2048 + bj * 128 + n * 16) = v;
                        ss += v[0] * v[0] + v[1] * v[1] + v[2] * v[2] + v[3] * v[3];
                    }
                ss += __shfl_xor(ss, 16); ss += __shfl_xor(ss, 32);
                if (fq == 0) part[(size_t)row * 32 + u.pn * 4 + wc] = ss;
            }
        }
    }
};

struct TDesc { const float* src; bf16_t* dst; int lds, ldd; };
DI TDesc tile_desc(const Params& P, int t) {
    bf16_t* win_t = (bf16_t*)(P.ws + WS_WIN_T); bf16_t* w2a = (bf16_t*)(P.ws + WS_W2A_T); bf16_t* w2b = (bf16_t*)(P.ws + WS_W2B_T);
    bf16_t* wdn = (bf16_t*)(P.ws + WS_WDN_T); bf16_t* wout = (bf16_t*)(P.ws + WS_WOUT_T);
    constexpr int T_IN = 329 * 32, T_ATT = 1024, T_DN = 2048;
    TDesc d;
    if (t < T_IN) {
        const int nt = t >> 5, kt = t & 31; const int col = nt * 64;
        d.src = P.w_in + (size_t)(kt * 64) * 21056 + col; d.lds = 21056;
        if (col < 16960) { d.dst = win_t + (size_t)col * 2048 + kt * 64; d.ldd = 2048; }
        else if (col < 16960 + 2048) { d.dst = w2a + (size_t)(col - 16960) * 4096 + kt * 64; d.ldd = 4096; }
        else { d.dst = w2b + (size_t)(col - 16960 - 2048) * 4096 + kt * 64; d.ldd = 4096; }
    } else if (t < T_IN + T_ATT) {
        const int q = t - T_IN; const int nt = q >> 5, kt = q & 31;
        d.src = P.w_att + (size_t)(kt * 64) * 2048 + nt * 64; d.lds = 2048; d.dst = w2a + (size_t)(nt * 64) * 4096 + 2048 + kt * 64; d.ldd = 4096;
    } else if (t < T_IN + T_ATT + T_DN) {
        const int q = t - T_IN - T_ATT; const int nt = q >> 6, kt = q & 63;
        d.src = P.w_dn + (size_t)(kt * 64) * 2048 + nt * 64; d.lds = 2048; d.dst = wdn + (size_t)(nt * 64) * 4096 + kt * 64; d.ldd = 4096;
    } else {
        const int q = t - T_IN - T_ATT - T_DN; const int nt = q >> 5, kt = q & 31;
        d.src = P.w_out + (size_t)(kt * 64) * 2048 + nt * 64; d.lds = 2048; d.dst = wout + (size_t)(nt * 64) * 2048 + kt * 64; d.ldd = 2048;
    }
    return d;
}

DI void phase_prologue(const Params& P, LAS unsigned char* L, int tid, int wave, int lane) {
    LAS float* tile = (LAS float*)L;
    bf16_t* win_t = (bf16_t*)(P.ws + WS_WIN_T);
    constexpr int T_ALL = 329 * 32 + 1024 + 2048 + 1024;
    {
        const int r0 = tid >> 4, c4 = (tid & 15) * 4, n = tid >> 3, kc = (tid & 7) * 8;
        int t = blockIdx.x;
        f32x4 v0 = (f32x4){0.f, 0.f, 0.f, 0.f}, v1 = v0;
        TDesc d{};
        if (t < T_ALL) { d = tile_desc(P, t); v0 = *(const f32x4*)(d.src + (size_t)r0 * d.lds + c4); v1 = *(const f32x4*)(d.src + (size_t)(r0 + 32) * d.lds + c4); }
        while (t < T_ALL) {
            tile[r0 * 65 + c4 + 0] = v0[0]; tile[r0 * 65 + c4 + 1] = v0[1]; tile[r0 * 65 + c4 + 2] = v0[2]; tile[r0 * 65 + c4 + 3] = v0[3];
            tile[(r0 + 32) * 65 + c4 + 0] = v1[0]; tile[(r0 + 32) * 65 + c4 + 1] = v1[1]; tile[(r0 + 32) * 65 + c4 + 2] = v1[2]; tile[(r0 + 32) * 65 + c4 + 3] = v1[3];
            lds_barrier();
            const TDesc cur = d;
            t += gridDim.x;
            if (t < T_ALL) { d = tile_desc(P, t); v0 = *(const f32x4*)(d.src + (size_t)r0 * d.lds + c4); v1 = *(const f32x4*)(d.src + (size_t)(r0 + 32) * d.lds + c4); }
            float f[8];
#pragma unroll
            for (int e = 0; e < 8; ++e) f[e] = tile[(kc + e) * 65 + n];
            u32x4 w; w.x = pk_bf16(f[0], f[1]); w.y = pk_bf16(f[2], f[3]); w.z = pk_bf16(f[4], f[5]); w.w = pk_bf16(f[6], f[7]);
            *(u32x4*)(cur.dst + (size_t)n * cur.ldd + kc) = w;
            lds_barrier();
        }
    }
    {
        u32x4* z = (u32x4*)(win_t + (size_t)16960 * 2048);
        for (int i = blockIdx.x * 512 + tid; i < 192 * 2048 / 8; i += gridDim.x * 512) z[i] = (u32x4){0u, 0u, 0u, 0u};
    }
    bf16_t* hoa = (bf16_t*)P.out;
    f32x4 nw[8];
#pragma unroll
    for (int i = 0; i < 8; ++i) nw[i] = *(const f32x4*)(P.norm_w + (i * 64 + lane) * 4);
    for (int row = blockIdx.x * 8 + wave; row < MTOK; row += gridDim.x * 16) {
        const int row2 = row + gridDim.x * 8; const bool has2 = row2 < MTOK;
        const float* xr = P.x + (size_t)row * 2048; const float* xr2 = P.x + (size_t)(has2 ? row2 : row) * 2048;
        f32x4 v[8], u[8]; float ss = 0.f, ss2 = 0.f;
#pragma unroll
        for (int i = 0; i < 8; ++i) { v[i] = *(const f32x4*)(xr + (i * 64 + lane) * 4); u[i] = *(const f32x4*)(xr2 + (i * 64 + lane) * 4); }
#pragma unroll
        for (int i = 0; i < 8; ++i) {
            ss += v[i][0] * v[i][0] + v[i][1] * v[i][1] + v[i][2] * v[i][2] + v[i][3] * v[i][3];
            ss2 += u[i][0] * u[i][0] + u[i][1] * u[i][1] + u[i][2] * u[i][2] + u[i][3] * u[i][3];
        }
#pragma unroll
        for (int d = 1; d < 64; d <<= 1) { ss += __shfl_xor(ss, d); ss2 += __shfl_xor(ss2, d); }
        const float rs = rsqrtf(ss * (1.f / 2048.f) + 1e-6f), rs2 = rsqrtf(ss2 * (1.f / 2048.f) + 1e-6f);
#pragma unroll
        for (int i = 0; i < 8; ++i) {
            const f32x4 w = nw[i];
            u32x2 o; o.x = pk_bf16(v[i][0] * rs * w[0], v[i][1] * rs * w[1]); o.y = pk_bf16(v[i][2] * rs * w[2], v[i][3] * rs * w[3]);
            *(u32x2*)(hoa + (size_t)row * 4096 + (i * 64 + lane) * 4) = o;
            if (has2) {
                u32x2 o2; o2.x = pk_bf16(u[i][0] * rs2 * w[0], u[i][1] * rs2 * w[1]); o2.y = pk_bf16(u[i][2] * rs2 * w[2], u[i][3] * rs2 * w[3]);
                *(u32x2*)(hoa + (size_t)row2 * 4096 + (i * 64 + lane) * 4) = o2;
            }
        }
    }
}

constexpr int A_KA = 0, A_VT = 27648;
DI void attn_item(const Params& P, LAS unsigned char* L, int item, int tid, int wave, int lane, int dry = 0) {
    const int tb = item & 31, kvh = (item >> 5) & 3, b = item >> 7;
    const int t0 = tb * 64, l15 = lane & 15, g = lane >> 4;
    const bf16_t* qkv = (const bf16_t*)(P.ws + WS_QKVA) + (size_t)b * SEQ * 2560;
    bf16_t* hoa = (bf16_t*)P.out;
#pragma unroll
    for (int i = 0; i < 3; ++i) {
        const int id = tid + 512 * i, row = id >> 3, dc = id & 7, tok = t0 - 128 + row;
        u32x4 kv = (u32x4){0u, 0u, 0u, 0u}, vv = kv;
        if (tok >= 0) { const bf16_t* p = qkv + (size_t)tok * 2560 + 2048 + kvh * 64 + dc * 8; kv = *(const u32x4*)p; vv = *(const u32x4*)(p + 256); }
        *(LAS u32x4*)(L + A_KA + row * 144 + dc * 16) = kv;
#pragma unroll
        for (int e = 0; e < 8; ++e) {
            const unsigned wv = vv[e >> 1]; const unsigned short val = (unsigned short)((e & 1) ? (wv >> 16) : (wv & 0xffffu));
            *(LAS unsigned short*)(L + A_VT + (dc * 8 + e) * 400 + row * 2) = val;
        }
    }
    lds_barrier();
    const int head = kvh * 8 + wave;
    const float sink = P.sinks[head];
    const int A_OT = 53248 + wave * 2304;
    const int otok = lane >> 2, och = lane & 3;
    for (int a = 0; a < 4; ++a) {
        const bf16_t* qp = qkv + (size_t)(t0 + 16 * a + l15) * 2560 + head * 64 + 8 * g;
        const bf16x8 q0 = *(const bf16x8*)qp, q1 = *(const bf16x8*)(qp + 32);
        bf16_t* zp = hoa + (size_t)(b * SEQ + t0 + 16 * a + otok) * 4096 + 2048 + head * 64 + 16 * och;
        const u32x4 zz0 = *(const u32x4*)zp, zz1 = *(const u32x4*)(zp + 8);
        f32x4 s[9];
#pragma unroll
        for (int i = 0; i < 9; ++i) {
            const int ko = A_KA + (16 * (a + i) + l15) * 144 + 16 * g;
            f32x4 z = (f32x4){0.f, 0.f, 0.f, 0.f};
            z = mfma32(lds16(L, ko), q0, z); z = mfma32(lds16(L, ko + 64), q1, z); s[i] = z;
        }
        const int qi = 16 * a + l15;
        float m = -INFINITY;
#pragma unroll
        for (int i = 0; i < 9; ++i)
#pragma unroll
            for (int j = 0; j < 4; ++j) {
                const int kk = 16 * (a + i) + 4 * g + j;
                const bool valid = (kk > qi) && (kk <= qi + 128) && (t0 - 128 + kk >= 0);
                const float sv = valid ? s[i][j] * 0.125f : -INFINITY;
                s[i][j] = sv; m = fmaxf(m, sv);
            }
        m = fmaxf(m, __shfl_xor(m, 16)); m = fmaxf(m, __shfl_xor(m, 32)); m = fmaxf(m, sink);
        float sum = 0.f;
#pragma unroll
        for (int i = 0; i < 9; ++i)
#pragma unroll
            for (int j = 0; j < 4; ++j) { const float p = __expf(s[i][j] - m); s[i][j] = p; sum += p; }
        sum += __shfl_xor(sum, 16); sum += __shfl_xor(sum, 32);
        const float inv = 1.f / (sum + __expf(sink - m));
        f32x4 o[4];
#pragma unroll
        for (int dt = 0; dt < 4; ++dt) o[dt] = (f32x4){0.f, 0.f, 0.f, 0.f};
#pragma unroll
        for (int i = 0; i < 9; ++i) {
            const bf16x4 pa = pack4(s[i][0] * inv, s[i][1] * inv, s[i][2] * inv, s[i][3] * inv);
#pragma unroll
            for (int dt = 0; dt < 4; ++dt) o[dt] = mfma16(pa, lds8(L, A_VT + (16 * dt + l15) * 400 + (16 * (a + i) + 4 * g) * 2), o[dt]);
        }
#pragma unroll
        for (int j = 0; j < 4; ++j)
#pragma unroll
            for (int dt = 0; dt < 4; ++dt)
                *(LAS unsigned short*)(L + A_OT + (4 * g + j) * 144 + (16 * dt + l15) * 2) = (unsigned short)(pk_bf16(o[dt][j], 0.f) & 0xffffu);
        asm volatile("s_waitcnt lgkmcnt(0)" ::: "memory");
        {
            const u32x4 o0 = *(const LAS u32x4*)(L + A_OT + otok * 144 + och * 32), o1 = *(const LAS u32x4*)(L + A_OT + otok * 144 + och * 32 + 16);
            u32x4 w0, w1;
#pragma unroll
            for (int e = 0; e < 4; ++e) {
                w0[e] = pk_bf16(bflo(o0[e]) * siluf_(bflo(zz0[e])), bfhi(o0[e]) * siluf_(bfhi(zz0[e])));
                w1[e] = pk_bf16(bflo(o1[e]) * siluf_(bflo(zz1[e])), bfhi(o1[e]) * siluf_(bfhi(zz1[e])));
            }
            bf16_t* op = dry ? ((bf16_t*)(P.ws + WS_WIN_T) + ((size_t)(zp - hoa) & 0x1fffff0u)) : zp;
            *(u32x4*)op = w0; *(u32x4*)(op + 8) = w1;
        }
        asm volatile("s_waitcnt lgkmcnt(0)" ::: "memory");
    }
    lds_barrier();
}

constexpr int D_QS = 0, D_KS = 17408, D_WL = 34816, D_VS = 52224, D_AB = 70656, D_MT = 79872, D_TB = 89088, D_TBG = 98304, D_QKM = 107520,
              D_XB = 116736, D_YB = 125952, D_YTB = 135168, D_GC = 144384, D_BETA = 144640, D_EG = 144896, D_RED = 145152, D_CW = 147200;
static_assert(D_CW + 6144 <= LDS_BYTES, "lds");

template <bool DO_X, bool DO_Y, bool DO_YROW>
DI void neu_step(LAS unsigned char* L, int xin, int yin, int ytin, int xout, int yout, int ytout, f32x4& xacc, int ti, int tj, int blk, int l15, int g) {
    const int ra = (16 * ti + l15) * 144 + 16 * g + blk * 64, rb = (16 * tj + l15) * 144 + 16 * g + blk * 64;
    const int wo = (16 * tj + l15) * 144 + (16 * ti + 4 * g) * 2;
    const f32x4 z = (f32x4){0.f, 0.f, 0.f, 0.f};
    const bf16x8 yta = lds16(L, ytin + ra);
    if (DO_Y) {
        const f32x4 y = mfma32(lds16(L, yin + ra), lds16(L, ytin + rb), z);
        st8(L, ytout + wo, pack4(y[0], y[1], y[2], y[3]));
        if (DO_YROW) {
            const f32x4 yt = mfma32(yta, lds16(L, yin + rb), z);
            st8(L, yout + wo, pack4(yt[0], yt[1], yt[2], yt[3]));
        }
    }
    if (DO_X) {
        const f32x4 x = mfma32(yta, lds16(L, xin + rb), xacc);
        xacc = x;
        st8(L, xout + wo, pack4(x[0], x[1], x[2], x[3]));
    }
}

DI void deltanet_seq(const Params& P, LAS unsigned char* L, int seq, int tid, int wave, int lane, int dry = 0) {
    const int vh = seq & 31, b = seq >> 5, kh = vh >> 1;
    const int l15 = lane & 15, g = lane >> 4;
    const bf16_t* dqkv = (const bf16_t*)(P.ws + WS_DQKV) + (size_t)b * SEQ * 8192;
    bf16_t* dz = (bf16_t*)(P.ws + WS_DZ) + (size_t)b * SEQ * 4096 + vh * 128;
    const float* garr = (const float*)(P.ws + WS_G) + (size_t)b * SEQ * 32 + vh;
    const float* barr = (const float*)(P.ws + WS_BETA) + (size_t)b * SEQ * 32 + vh;
    LAS float* GC = (LAS float*)(L + D_GC); LAS float* BETA = (LAS float*)(L + D_BETA); LAS float* EG = (LAS float*)(L + D_EG);
    LAS float* RED = (LAS float*)(L + D_RED); LAS float* CW = (LAS float*)(L + D_CW);
    const int cbq = kh * 128, cbk = 2048 + kh * 128, cbv = 4096 + vh * 128;
    for (int i = tid; i < 1536; i += 512) { const int X = i >> 9, tap = (i >> 7) & 3, ch = i & 127; const int cb = X == 0 ? cbq : (X == 1 ? cbk : cbv); CW[i] = P.conv_w[(size_t)tap * 8192 + cb + ch]; }
    const float dnw = P.dn_norm_w[16 * wave + l15];
    f32x4 Sacc[8];
#pragma unroll
    for (int i = 0; i < 8; ++i) Sacc[i] = (f32x4){0.f, 0.f, 0.f, 0.f};
    lds_barrier();

    LAS unsigned char* const L0 = L;
    for (int n = 0; n < 32; ++n) {
        const int t0 = n * 64;
        int lz = 0; asm volatile("" : "+v"(lz));
        LAS unsigned char* const L = L0 + lz;
        LAS float* GC = (LAS float*)(L + D_GC); LAS float* BETA = (LAS float*)(L + D_BETA); LAS float* EG = (LAS float*)(L + D_EG);
        LAS float* RED = (LAS float*)(L + D_RED); LAS float* CW = (LAS float*)(L + D_CW);
        {
            asm volatile("" ::: "memory");
            const int grp = tid & 15, tokb = tid >> 4;
            const int c0 = 2 * tokb;
            u32x4 rawx[3][5];
#pragma unroll
            for (int X = 0; X < 3; ++X) {
                const int cb = (X == 0 ? cbq : (X == 1 ? cbk : cbv)) + grp * 8;
#pragma unroll
                for (int r = 0; r < 5; ++r) { const int tt = t0 + c0 - 3 + r; rawx[X][r] = (tt >= 0) ? *(const u32x4*)(dqkv + (size_t)tt * 8192 + cb) : (u32x4){0u, 0u, 0u, 0u}; }
            }
#pragma unroll
            for (int X = 0; X < 3; ++X) {
                float accA[8], accB[8];
#pragma unroll
                for (int e = 0; e < 8; ++e) { accA[e] = 0.f; accB[e] = 0.f; }
#pragma unroll
                for (int tap = 0; tap < 4; ++tap) {
                    const f32x4 w0 = *(const LAS f32x4*)(CW + (X * 4 + tap) * 128 + grp * 8), w1 = *(const LAS f32x4*)(CW + (X * 4 + tap) * 128 + grp * 8 + 4);
                    const u32x4 u = rawx[X][tap], v = rawx[X][tap + 1];
                    accA[0] += w0[0] * bflo(u.x); accA[1] += w0[1] * bfhi(u.x); accA[2] += w0[2] * bflo(u.y); accA[3] += w0[3] * bfhi(u.y);
                    accA[4] += w1[0] * bflo(u.z); accA[5] += w1[1] * bfhi(u.z); accA[6] += w1[2] * bflo(u.w); accA[7] += w1[3] * bfhi(u.w);
                    accB[0] += w0[0] * bflo(v.x); accB[1] += w0[1] * bfhi(v.x); accB[2] += w0[2] * bflo(v.y); accB[3] += w0[3] * bfhi(v.y);
                    accB[4] += w1[0] * bflo(v.z); accB[5] += w1[1] * bfhi(v.z); accB[6] += w1[2] * bflo(v.w); accB[7] += w1[3] * bfhi(v.w);
                }
                float ssA = 0.f, ssB = 0.f;
#pragma unroll
                for (int e = 0; e < 8; ++e) { accA[e] = siluf_(accA[e]); ssA += accA[e] * accA[e]; accB[e] = siluf_(accB[e]); ssB += accB[e] * accB[e]; }
                if (X < 2) {
                    ssA = sum16(ssA); ssB = sum16(ssB);
                    const float sc = (X == 0 ? 0.08838834764831845f : 1.f);
                    const float rA = rsqrtf(ssA + 1e-6f) * sc, rB = rsqrtf(ssB + 1e-6f) * sc;
#pragma unroll
                    for (int e = 0; e < 8; ++e) { accA[e] *= rA; accB[e] *= rB; }
                }
                u32x4 wA, wB;
                wA.x = pk_bf16(accA[0], accA[1]); wA.y = pk_bf16(accA[2], accA[3]); wA.z = pk_bf16(accA[4], accA[5]); wA.w = pk_bf16(accA[6], accA[7]);
                wB.x = pk_bf16(accB[0], accB[1]); wB.y = pk_bf16(accB[2], accB[3]); wB.z = pk_bf16(accB[4], accB[5]); wB.w = pk_bf16(accB[6], accB[7]);
                const int base = (X == 0 ? D_QS : (X == 1 ? D_KS : D_VS)) + c0 * 272 + grp * 16;
                *(LAS u32x4*)(L + base) = wA; *(LAS u32x4*)(L + base + 272) = wB;
            }
            if (wave == 0) {
                float gv = garr[(size_t)(t0 + lane) * 32];
#pragma unroll
                for (int d = 1; d < 64; d <<= 1) { const float o = __shfl_up(gv, d); if (lane >= d) gv += o; }
                GC[lane] = gv; EG[lane] = __expf(gv); BETA[lane] = barr[(size_t)(t0 + lane) * 32];
            }
        }
        lds_barrier();
        const int blk = wave >> 2, ti0 = 2 * blk + ((wave >> 1) & 1), tj0 = 2 * blk + (wave & 1), tj1 = 2 * (1 - blk) + (wave & 1);
        f32x4 xacc;
        {
#pragma unroll
        for (int tt = 0; tt < 2; ++tt) {
            const int ti = ti0, tj = tt ? tj1 : tj0;
            const int ra = D_KS + (16 * ti + l15) * 272 + 16 * g, rb = D_KS + (16 * tj + l15) * 272 + 16 * g, rq = D_QS + (16 * tj + l15) * 272 + 16 * g;
            f32x4 kk = (f32x4){0.f, 0.f, 0.f, 0.f}, qk = kk;
#pragma unroll
            for (int ks = 0; ks < 4; ++ks) {
                const bf16x8 ka = lds16(L, ra + ks * 64);
                kk = mfma32(ka, lds16(L, rb + ks * 64), kk);
                qk = mfma32(ka, lds16(L, rq + ks * 64), qk);
            }
            const int c = 16 * tj + l15; const float gc_c = GC[c], be_c = BETA[c];
            float xa[4], ya[4], yta[4], qm[4];
#pragma unroll
            for (int j = 0; j < 4; ++j) {
                const int r = 16 * ti + 4 * g + j; const float gc_r = GC[r], be_r = BETA[r];
                const float dcr = __expf(fminf(gc_c - gc_r, 0.f)), drc = __expf(fminf(gc_r - gc_c, 0.f));
                const float a_cr = (c > r) ? be_c * kk[j] * dcr : 0.f;
                const float a_rc = (r > c) ? be_r * kk[j] * drc : 0.f;
                xa[j] = ((c == r) ? 1.f : 0.f) - a_cr; ya[j] = a_cr; yta[j] = a_rc;
                qm[j] = (c >= r) ? qk[j] * dcr : 0.f;
            }
            if (tt == 0) xacc = (f32x4){xa[0], xa[1], xa[2], xa[3]};
            const int wo = (16 * tj + l15) * 144 + (16 * ti + 4 * g) * 2;
            st8(L, D_XB + wo, pack4(xa[0], xa[1], xa[2], xa[3]));
            st8(L, D_YB + wo, pack4(ya[0], ya[1], ya[2], ya[3]));
            st8(L, D_AB + wo, pack4(ya[0], ya[1], ya[2], ya[3]));
            st8(L, D_YTB + wo, pack4(yta[0], yta[1], yta[2], yta[3]));
            st8(L, D_QKM + wo, pack4(qm[0], qm[1], qm[2], qm[3]));
        }
        lds_barrier();
        neu_step<false, true, true>(L, 0, D_YB, D_YTB, 0, D_TBG, D_WL, xacc, ti0, tj0, blk, l15, g);
        lds_barrier();
        neu_step<true, true, true>(L, D_XB, D_TBG, D_WL, D_TB, D_YB, D_YTB, xacc, ti0, tj0, blk, l15, g);
        lds_barrier();
        neu_step<true, true, true>(L, D_TB, D_YB, D_YTB, D_XB, D_TBG, D_WL, xacc, ti0, tj0, blk, l15, g);
        lds_barrier();
        neu_step<true, true, false>(L, D_XB, D_TBG, D_WL, D_TB, 0, D_YTB, xacc, ti0, tj0, blk, l15, g);
        lds_barrier();
        neu_step<true, false, false>(L, D_TB, 0, D_YTB, D_XB, 0, 0, xacc, ti0, tj0, blk, l15, g);
        lds_barrier();
        {
            const int wo0 = (16 * tj0 + l15) * 144 + (16 * ti0 + 4 * g) * 2;
            const LAS float* be = BETA + 16 * ti0 + 4 * g; const LAS float* eg = EG + 16 * ti0 + 4 * g;
            const float t0 = xacc[0] * be[0], t1 = xacc[1] * be[1], t2 = xacc[2] * be[2], t3 = xacc[3] * be[3];
            st8(L, D_TB + wo0, pack4(t0, t1, t2, t3));
            st8(L, D_TBG + wo0, pack4(t0 * eg[0], t1 * eg[1], t2 * eg[2], t3 * eg[3]));
        }
        const int ct2 = 2 + ((wave >> 1) & 1), rt2 = wave & 1;
        if (wave < 4) {
            const bf16x8 aa = lds16(L, D_AB + (16 * ct2 + l15) * 144 + 16 * g);
            const int tq = D_XB + (8 * g + (l15 >> 2)) * 144 + (16 * rt2 + 4 * (l15 & 3)) * 2;
            const bf16x8 tb = cat8(lds_tr(L, tq), lds_tr(L, tq + 4 * 144));
            const f32x4 m = mfma32(aa, tb, (f32x4){0.f, 0.f, 0.f, 0.f});
            st8(L, D_MT + (16 * rt2 + l15) * 144 + (16 * (ct2 - 2) + 4 * g) * 2, pack4(m[0], m[1], m[2], m[3]));
        } else {
            const int zo = (16 * ((wave >> 1) & 1) + l15) * 144 + (16 * (2 + (wave & 1)) + 4 * g) * 2;
            st8(L, D_TB + zo, pack4(0.f, 0.f, 0.f, 0.f)); st8(L, D_TBG + zo, pack4(0.f, 0.f, 0.f, 0.f));
        }
        lds_barrier();
        if (wave < 4) {
            const f32x4 t = mfma32(lds16(L, D_MT + (16 * rt2 + l15) * 144 + 16 * g), lds16(L, D_XB + (16 * ct2 + l15) * 144 + 64 + 16 * g), (f32x4){0.f, 0.f, 0.f, 0.f});
            const LAS float* be = BETA + 16 * rt2 + 4 * g; const LAS float* eg = EG + 16 * rt2 + 4 * g;
            const float t0 = -t[0] * be[0], t1 = -t[1] * be[1], t2 = -t[2] * be[2], t3 = -t[3] * be[3];
            const int wo2 = (16 * ct2 + l15) * 144 + (16 * rt2 + 4 * g) * 2;
            st8(L, D_TB + wo2, pack4(t0, t1, t2, t3));
            st8(L, D_TBG + wo2, pack4(t0 * eg[0], t1 * eg[1], t2 * eg[2], t3 * eg[3]));
        }
        lds_barrier();
        }
        bf16_t* zrow = dz + (size_t)(t0 + (tid >> 3)) * 4096 + (tid & 7) * 16;
        const u32x4 zz0 = *(const u32x4*)zrow, zz1 = *(const u32x4*)(zrow + 8);
        f32x4 vn[4];
#pragma unroll
        for (int ct = 0; ct < 4; ++ct) {
            const int rt = (16 * ct + l15) * 144 + 16 * g;
            const int tq = (8 * g + (l15 >> 2)) * 272 + (16 * wave + 4 * (l15 & 3)) * 2;
            f32x4 u = (f32x4){0.f, 0.f, 0.f, 0.f}, wt = u;
#pragma unroll
            for (int ks = 0; ks < 2; ++ks) {
                const bf16x8 vb = cat8(lds_tr(L, D_VS + tq + ks * 32 * 272), lds_tr(L, D_VS + tq + ks * 32 * 272 + 4 * 272));
                const bf16x8 ka = cat8(lds_tr(L, D_KS + tq + ks * 32 * 272), lds_tr(L, D_KS + tq + ks * 32 * 272 + 4 * 272));
                u = mfma32(lds16(L, D_TB + rt + ks * 64), vb, u);
                wt = mfma32(ka, lds16(L, D_TBG + rt + ks * 64), wt);
            }
            vn[ct] = u;
            st8(L, D_WL + (16 * ct + l15) * 272 + (16 * wave + 4 * g) * 2, pack4(wt[0], wt[1], wt[2], wt[3]));
        }
        lds_barrier();
        f32x4 oq[4];
        {
            bf16x8 sb[4];
#pragma unroll
            for (int kb = 0; kb < 4; ++kb) sb[kb] = pack8(Sacc[2 * kb], Sacc[2 * kb + 1]);
#pragma unroll
            for (int ct = 0; ct < 4; ++ct) {
                f32x4 ws = (f32x4){0.f, 0.f, 0.f, 0.f}, qs = ws;
                bf16x8 aw[4], aq[4];
#pragma unroll
                for (int kb = 0; kb < 4; ++kb) {
                    aw[kb] = lds_perm(L, D_WL + (16 * ct + l15) * 272 + (32 * kb + 4 * g) * 2);
                    aq[kb] = lds_perm(L, D_QS + (16 * ct + l15) * 272 + (32 * kb + 4 * g) * 2);
                }
                __builtin_amdgcn_sched_barrier(0);
#pragma unroll
                for (int kb = 0; kb < 4; ++kb) { ws = mfma32(aw[kb], sb[kb], ws); qs = mfma32(aq[kb], sb[kb], qs); }
                __builtin_amdgcn_sched_barrier(0);
                vn[ct] = vn[ct] - ws;
#pragma unroll
                for (int j = 0; j < 4; ++j) qs[j] *= EG[16 * ct + 4 * g + j];
                oq[ct] = qs;
            }
        }
        {
            const bf16x8 vb0 = pack8(vn[0], vn[1]), vb1 = pack8(vn[2], vn[3]);
#pragma unroll
            for (int ct = 0; ct < 4; ++ct) {
                const int ro = D_QKM + (16 * ct + l15) * 144 + (4 * g) * 2;
                oq[ct] = mfma32(lds_perm(L, ro), vb0, oq[ct]);
                oq[ct] = mfma32(lds_perm(L, ro + 64), vb1, oq[ct]);
            }
            const float gl = GC[63], egl = __expf(gl);
            f32x4 vs[4];
#pragma unroll
            for (int ct = 0; ct < 4; ++ct)
#pragma unroll
                for (int j = 0; j < 4; ++j) vs[ct][j] = vn[ct][j] * __expf(gl - GC[16 * ct + 4 * g + j]);
            const bf16x8 sb0 = pack8(vs[0], vs[1]), sb1 = pack8(vs[2], vs[3]);
#pragma unroll
            for (int dp = 0; dp < 4; ++dp) {
                bf16x4 t[2][4];
#pragma unroll
                for (int u = 0; u < 2; ++u) {
                    const int tk = D_KS + (4 * g + (l15 >> 2)) * 272 + (16 * (2 * dp + u) + 4 * (l15 & 3)) * 2;
                    t[u][0] = lds_tr(L, tk); t[u][1] = lds_tr(L, tk + 16 * 272); t[u][2] = lds_tr(L, tk + 32 * 272); t[u][3] = lds_tr(L, tk + 48 * 272);
                }
                __builtin_amdgcn_sched_barrier(0);
#pragma unroll
                for (int u = 0; u < 2; ++u) {
                    f32x4 s = Sacc[2 * dp + u] * egl;
                    s = mfma32(cat8(t[u][0], t[u][1]), sb0, s);
                    s = mfma32(cat8(t[u][2], t[u][3]), sb1, s);
                    Sacc[2 * dp + u] = s;
                }
                __builtin_amdgcn_sched_barrier(0);
            }
        }
#pragma unroll
        for (int ct = 0; ct < 4; ++ct)
#pragma unroll
            for (int j = 0; j < 4; ++j) {
                const float ss = sum16(oq[ct][j] * oq[ct][j]);
                if (l15 == 0) RED[(16 * ct + 4 * g + j) * 8 + wave] = ss;
            }
        lds_barrier();
#pragma unroll
        for (int ct = 0; ct < 4; ++ct)
#pragma unroll
            for (int j = 0; j < 4; ++j) {
                const int c = 16 * ct + 4 * g + j;
                const f32x4 r0 = *(const LAS f32x4*)(RED + c * 8), r1 = *(const LAS f32x4*)(RED + c * 8 + 4);
                const float tot = r0[0] + r0[1] + r0[2] + r0[3] + r1[0] + r1[1] + r1[2] + r1[3];
                const float rs = rsqrtf(tot * (1.f / 128.f) + 1e-6f);
                *(LAS unsigned short*)(L + D_XB + c * 272 + (16 * wave + l15) * 2) = (unsigned short)(pk_bf16(oq[ct][j] * rs * dnw, 0.f) & 0xffffu);
            }
        lds_barrier();
        {
            const u32x4 o0 = *(const LAS u32x4*)(L + D_XB + (tid >> 3) * 272 + (tid & 7) * 32), o1 = *(const LAS u32x4*)(L + D_XB + (tid >> 3) * 272 + (tid & 7) * 32 + 16);
            u32x4 w0, w1;
#pragma unroll
            for (int e = 0; e < 4; ++e) {
                w0[e] = pk_bf16(bflo(o0[e]) * siluf_(bflo(zz0[e])), bfhi(o0[e]) * siluf_(bfhi(zz0[e])));
                w1[e] = pk_bf16(bflo(o1[e]) * siluf_(bflo(zz1[e])), bfhi(o1[e]) * siluf_(bfhi(zz1[e])));
            }
            bf16_t* op = dry ? ((bf16_t*)(P.ws + WS_WIN_T) + ((size_t)(zrow - (bf16_t*)(P.ws + WS_DZ)) & 0x1fffff0u)) : zrow;
            *(u32x4*)op = w0; *(u32x4*)(op + 8) = w1;
        }
    }
    lds_barrier();
}


#define XB_TMO      128
#define XB_XCNT(j)  (256  + 64 * (j))
#define XB_XSUB(j)  (1280 + 64 * (j))
#define XB_XGEN(j)  (2304 + 64 * (j))
#define XB_TOP      3328
#define XB_TOPGEN   3392
#define XCD_BAR_WORDS 3456
#define XB_SPIN_CAP (1u << 18)
DI unsigned xb_ld(unsigned* p)              { return __hip_atomic_load(p, __ATOMIC_RELAXED, __HIP_MEMORY_SCOPE_AGENT); }
DI unsigned xb_add(unsigned* p, unsigned v) { return __hip_atomic_fetch_add(p, v, __ATOMIC_RELAXED, __HIP_MEMORY_SCOPE_AGENT); }
DI unsigned xb_xcc_id() { return (unsigned)__builtin_amdgcn_s_getreg((3 << 11) | 20) & 0xFu; }
#define XB_SPIN(cond, bar) do { unsigned _sp = 0; while (cond) { __builtin_amdgcn_s_sleep(1); \
    if ((++_sp & 255u) == 0u) { if (xb_ld(&(bar)[XB_TMO])) break; if (_sp > XB_SPIN_CAP) { atomicAdd(&(bar)[XB_TMO], 1u); break; } } } } while (0)
struct XcdBarrier { unsigned* bar; unsigned x; volatile LAS unsigned* st; };
DI XcdBarrier xcd_barrier_post(unsigned* bar, volatile LAS unsigned* st) {
    XcdBarrier b; b.bar = bar; b.x = xb_xcc_id(); b.st = st;
    if (threadIdx.x == 0) (void)xb_add(&bar[XB_XCNT(b.x)], 1u);
    return b;
}
DI void xcd_barrier_complete(unsigned* bar, unsigned x, unsigned& nloc, unsigned& nx) {
    const unsigned G = gridDim.x * gridDim.y * gridDim.z;
    unsigned sum, cnt, mine, sp = 0u;
    for (;;) {
        sum = 0u; cnt = 0u; mine = 0u;
#pragma unroll
        for (unsigned j = 0; j < 16; ++j) { const unsigned c = xb_ld(&bar[XB_XCNT(j)]); sum += c; cnt += (c > 0u) ? 1u : 0u; mine = (j == x) ? c : mine; }
        if (sum == G) break;
        __builtin_amdgcn_s_sleep(1);
        if ((++sp & 255u) == 0u) { if (xb_ld(&bar[XB_TMO])) break; if (sp > XB_SPIN_CAP) { atomicAdd(&bar[XB_TMO], 1u); break; } }
    }
    nloc = mine > 0u ? mine : 1u; nx = cnt > 0u ? cnt : 1u;
}
DI void xcd_barrier(const XcdBarrier& b) {
    asm volatile("s_waitcnt vmcnt(0)" ::: "memory");
    __syncthreads();
    if (threadIdx.x == 0) {
        unsigned* bar = b.bar;
        __builtin_amdgcn_s_waitcnt(0);
        unsigned nloc = b.st[0], nx = b.st[1];
        if (nloc == 0u) { xcd_barrier_complete(bar, b.x, nloc, nx); b.st[0] = nloc; b.st[1] = nx; }
        const unsigned old = xb_add(&bar[XB_XSUB(b.x)], 1u);
        const unsigned gen = old / nloc;
        if (old + 1u == (gen + 1u) * nloc) {
            __builtin_amdgcn_fence(__ATOMIC_RELEASE, "agent");
            asm volatile("s_waitcnt vmcnt(0)" ::: "memory");
            const unsigned og = xb_add(&bar[XB_TOP], 1u);
            const unsigned tg = og / nx;
            if (og + 1u == (tg + 1u) * nx) xb_add(&bar[XB_TOPGEN], 1u);
            else XB_SPIN(xb_ld(&bar[XB_TOPGEN]) == tg, bar);
            __builtin_amdgcn_fence(__ATOMIC_ACQUIRE, "agent");
            xb_add(&bar[XB_XGEN(b.x)], 1u);
            asm volatile("s_waitcnt vmcnt(0)" ::: "memory");
        } else {
            XB_SPIN(xb_ld(&bar[XB_XGEN(b.x)]) == gen, bar);
            __builtin_amdgcn_fence(__ATOMIC_ACQUIRE, "agent");
            asm volatile("s_waitcnt vmcnt(0)" ::: "memory");
        }
    }
    __syncthreads();
}

__global__ void __launch_bounds__(512, 2) fwd_megakernel(Params P) {
    extern __shared__ __attribute__((aligned(16))) unsigned char lds_raw[];
    LAS unsigned char* L = (LAS unsigned char*)lds_raw;
    cg::grid_group grid = cg::this_grid();
#define FRESH_IDS const int tid = fresh_tid(), lane = tid & 63, wave = __builtin_amdgcn_readfirstlane(tid >> 6)
    const int G = gridDim.x, c = blockIdx.x;
    unsigned* const bar = (unsigned*)(P.ws + WS_BAR);
    {
        if (threadIdx.x == 0) { *(volatile LAS unsigned*)(L + LDS_BYTES - 16) = 0u; *(volatile LAS unsigned*)(L + LDS_BYTES - 12) = 0u; }
        __syncthreads();
    }
    const XcdBarrier xb = xcd_barrier_post(bar, (volatile LAS unsigned*)(L + LDS_BYTES - 16));
    if (P.ws == nullptr) grid.sync();
    bf16_t* hoa = (bf16_t*)P.out;

#ifndef PH_MASK
#define PH_MASK 0xFF
#endif
    if (PH_MASK & 1) { FRESH_IDS; phase_prologue(P, L, tid, wave, lane); }
    xcd_barrier(xb);
    if (PH_MASK & 2) {
        Sched1 S{(const char*)hoa, (const char*)(P.ws + WS_WIN_T), G, c};
        Epi1 E{(bf16_t*)(P.ws + WS_QKVA), hoa, (bf16_t*)(P.ws + WS_DQKV), (bf16_t*)(P.ws + WS_DZ), (float*)(P.ws + WS_BETA), (float*)(P.ws + WS_G), P.b_qkv, P.a_log, P.dt_bias};
        pg8::gemm_phase<Epi1, Sched1>(L, 4096, 2048, S, E);
    }
    xcd_barrier(xb);
    if (PH_MASK & 4) { FRESH_IDS; for (int item = c; item < 1024; item += G) attn_item(P, L, item, tid, wave, lane); }
    if (PH_MASK & 8) { FRESH_IDS; for (int seq = c; seq < 256; seq += G) deltanet_seq(P, L, seq, tid, wave, lane); }
    xcd_barrier(xb);
    if (PH_MASK & 16) {
        Sched2 S{(const char*)hoa, (const char*)(P.ws + WS_DZ), (const char*)(P.ws + WS_W2A_T), (const char*)(P.ws + WS_W2B_T), (const char*)(P.ws + WS_WDN_T), G, c};
        Epi2 E{(bf16_t*)(P.ws + WS_QKVA), P.ws + WS_GSCR + (size_t)c * 131072};
        pg8::gemm_phase<Epi2, Sched2>(L, 4096, 4096, S, E);
    }
    xcd_barrier(xb);
    if (PH_MASK & 32) {
        Sched3 S{(const char*)(P.ws + WS_QKVA), (const char*)(P.ws + WS_WOUT_T), G, c};
        Epi3 E{P.x, P.out, (float*)(P.ws + WS_PART)};
        pg8::gemm_phase<Epi3, Sched3>(L, 2048, 2048, S, E);
    }
    xcd_barrier(xb);
    {
        FRESH_IDS;
        const float* part = (const float*)(P.ws + WS_PART);
        f32x4 fw[8];
#pragma unroll
        for (int i = 0; i < 8; ++i) fw[i] = *(const f32x4*)(P.final_w + (i * 64 + lane) * 4);
        for (int row = c * 8 + wave; row < MTOK; row += G * 16) {
            const int row2r = row + G * 8; const bool has2 = row2r < MTOK; const int row2 = has2 ? row2r : row;
            float ss = part[(size_t)row * 32 + (lane & 31)], ss2 = part[(size_t)row2 * 32 + (lane & 31)];
            float* o = P.out + (size_t)row * 2048; float* o2 = P.out + (size_t)row2 * 2048;
            f32x4 v[8], u[8];
#pragma unroll
            for (int i = 0; i < 8; ++i) { v[i] = *(const f32x4*)(o + (i * 64 + lane) * 4); u[i] = *(const f32x4*)(o2 + (i * 64 + lane) * 4); }
#pragma unroll
            for (int d = 1; d < 32; d <<= 1) { ss += __shfl_xor(ss, d); ss2 += __shfl_xor(ss2, d); }
            const float rs = rsqrtf(ss * (1.f / 2048.f) + 1e-6f), rs2 = rsqrtf(ss2 * (1.f / 2048.f) + 1e-6f);
#pragma unroll
            for (int i = 0; i < 8; ++i) {
                const f32x4 w = fw[i];
                f32x4 a = v[i]; a[0] *= rs * w[0]; a[1] *= rs * w[1]; a[2] *= rs * w[2]; a[3] *= rs * w[3];
                *(f32x4*)(o + (i * 64 + lane) * 4) = a;
                if (has2) { f32x4 q = u[i]; q[0] *= rs2 * w[0]; q[1] *= rs2 * w[1]; q[2] *= rs2 * w[2]; q[3] *= rs2 * w[3]; *(f32x4*)(o2 + (i * 64 + lane) * 4) = q; }
            }
        }
    }
}

extern "C" void kernel_launch(void* const* d_in, const int* in_sizes, int n_in, void* d_out, int out_size, void* d_ws, size_t ws_size, hipStream_t stream) {
    static int grid_blocks = 0;
    if (grid_blocks == 0) {
        if (ws_size < WS_END) { fprintf(stderr, "kernel_launch: workspace too small: %zu < %zu\n", ws_size, (size_t)WS_END); grid_blocks = -1; return; }
        int dev = 0, cus = 0, per_cu = 0;
        hipGetDevice(&dev);
        hipDeviceGetAttribute(&cus, hipDeviceAttributeMultiprocessorCount, dev);
        if (hipFuncSetAttribute((const void*)fwd_megakernel, hipFuncAttributeMaxDynamicSharedMemorySize, LDS_BYTES) != hipSuccess) { fprintf(stderr, "kernel_launch: hipFuncSetAttribute failed\n"); }
        if (hipOccupancyMaxActiveBlocksPerMultiprocessor(&per_cu, (const void*)fwd_megakernel, 512, LDS_BYTES) != hipSuccess || per_cu < 1) { fprintf(stderr, "kernel_launch: occupancy query gives %d\n", per_cu); per_cu = 1; }
        (void)hipGetLastError();
        grid_blocks = cus * per_cu;
        if (grid_blocks > 256) grid_blocks = 256;
    }
    if (grid_blocks < 0) return;
    Params p{};
    p.x = (const float*)d_in[0]; p.norm_w = (const float*)d_in[1]; p.w_in = (const float*)d_in[2]; p.b_qkv = (const float*)d_in[3];
    p.sinks = (const float*)d_in[4]; p.conv_w = (const float*)d_in[5]; p.a_log = (const float*)d_in[6]; p.dt_bias = (const float*)d_in[7];
    p.dn_norm_w = (const float*)d_in[8]; p.w_att = (const float*)d_in[9]; p.w_dn = (const float*)d_in[10]; p.w_out = (const float*)d_in[11];
    p.final_w = (const float*)d_in[12]; p.out = (float*)d_out; p.ws = (unsigned char*)d_ws;
    if (hipMemsetAsync((char*)d_ws + WS_BAR, 0, WS_BAR_BYTES, stream) != hipSuccess) { fprintf(stderr, "kernel_launch: memset of the barrier words failed\n"); return; }
    void* args[] = {&p};
    hipError_t e = hipLaunchCooperativeKernel((const void*)fwd_megakernel, dim3(grid_blocks), dim3(512), args, LDS_BYTES, stream);
    if (e != hipSuccess) fprintf(stderr, "cooperative launch failed: %s (grid %d)\n", hipGetErrorString(e), grid_blocks);
}
```
